# Optimizing an MI355X kernel written in HIP

```python
import numpy as np
import jax, jax.numpy as jnp
from jax import lax


D_MODEL = 1024
BATCH = 16
SEQ = 2048
DEPTH = 2

GRID_W = 64
CTX_LEN = 256
HEAD_DIM = 64
RET_HEADS = D_MODEL // (2 * HEAD_DIM)
NA_HEADS = D_MODEL // (2 * HEAD_DIM)
RET_W = RET_HEADS * HEAD_DIM
NA_W = NA_HEADS * HEAD_DIM
MIX_W = RET_W + NA_W
AB_IN = 4 * RET_W + 3 * NA_W
RET_CHUNK = 128
RET_DECAY_BASE = 5.0
GN_EPS = 1e-5
NA_KH = 8
NA_KW = 16
SWA_HEADS = D_MODEL // HEAD_DIM
SWA_KV_HEADS = SWA_HEADS // 4
SWA_WINDOW = 128
SWA_BLOCK = 128
SWA_IN = (SWA_HEADS + 2 * SWA_KV_HEADS) * HEAD_DIM
ROPE_BASE = 10000.0
MOE_GROUPS = 4
MOE_EPG = 8
MOE_EXPERTS = MOE_GROUPS * MOE_EPG
MOE_TOPK = 2
MOE_FF = D_MODEL // 2
MOE_BLOCK = 128
NORM_EPS = 1e-6
NEG_INF = -1e30

kernel_name = 'hybrid_retention_natten_swa_hmoe_dit'


def rms_norm(x, g):
    xf = x.astype(jnp.float32)
    y = xf * lax.rsqrt(jnp.mean(xf * xf, axis=-1, keepdims=True) + NORM_EPS)
    return (y * g.astype(jnp.float32)).astype(x.dtype)


def modulate(h, shift, scale):
    return h * (1 + scale) + shift


def split_heads(t, n):
    return t.reshape(*t.shape[:-1], n, HEAD_DIM)


def axial_rope_tables(L):
    nf = HEAD_DIM // 4
    inv = ROPE_BASE ** (-jnp.arange(nf, dtype=jnp.float32) / nf)
    t = jnp.arange(L)
    row = (t // GRID_W).astype(jnp.float32)
    col = (t % GRID_W).astype(jnp.float32)
    ang = jnp.concatenate([row[:, None] * inv, col[:, None] * inv], axis=-1)
    return jnp.cos(ang), jnp.sin(ang)


def apply_rope(x, cos, sin):
    nf = x.shape[-1] // 4
    xr = x.reshape(*x.shape[:-1], 2, 2, nf)
    x1, x2 = xr[..., 0, :], xr[..., 1, :]
    c = cos.reshape(cos.shape[0], 1, 2, nf).astype(x.dtype)
    s = sin.reshape(sin.shape[0], 1, 2, nf).astype(x.dtype)
    out = jnp.stack([x1 * c - x2 * s, x2 * c + x1 * s], axis=-2)
    return out.reshape(x.shape)


def retention_scan(q, k, v, log_gamma, state0):
    b, h, L, dk = q.shape
    dv = v.shape[-1]
    n = L // RET_CHUNK
    lg = log_gamma.astype(jnp.float32)[:, None]
    pos = jnp.arange(RET_CHUNK, dtype=jnp.float32)
    rel = pos[:, None] - pos[None, :]
    intra = jnp.where(rel >= 0, jnp.exp(lg[:, :, None] * jnp.maximum(rel, 0.0)), 0.0)
    q_decay = jnp.exp(lg * (pos + 1.0))[..., None]
    k_decay = jnp.exp(lg * (RET_CHUNK - 1.0 - pos))[..., None]
    chunk_decay = jnp.exp(lg[:, 0] * RET_CHUNK)[:, None, None]

    def to_chunks(t):
        return t.reshape(b, h, n, RET_CHUNK, t.shape[-1]).transpose(2, 0, 1, 3, 4)

    def step(state, qkv):
        qc, kc, vc = qkv
        s = jnp.einsum('bhnd,bhmd->bhnm', qc, kc) * intra
        out = jnp.einsum('bhnm,bhme->bhne', s, vc) + jnp.einsum('bhnd,bhde->bhne', qc, state) * q_decay
        state = state * chunk_decay + jnp.einsum('bhmd,bhme->bhde', kc * k_decay, vc)
        return state, out

    state, out = lax.scan(step, state0, (to_chunks(q), to_chunks(k), to_chunks(v)))
    return out.transpose(1, 2, 0, 3, 4).reshape(b, h, L, dv), state


def retention_readout(o, gate, gain):
    o = o.transpose(0, 2, 1, 3)
    mu = jnp.mean(o, axis=-1, keepdims=True)
    var = jnp.mean(jnp.square(o - mu), axis=-1, keepdims=True)
    o = ((o - mu) * lax.rsqrt(var + GN_EPS)).reshape(gate.shape) * gain.astype(jnp.float32)
    return (jax.nn.silu(gate.astype(jnp.float32)) * o).astype(gate.dtype)


def context_attention(q, k, v, sink=None):
    b, lc, hq, d = q.shape
    hk = k.shape[2]
    g = hq // hk
    qg = q.reshape(b, lc, hk, g, d)
    s = jnp.einsum('bqkgd,bmkd->bkgqm', qg, k).astype(jnp.float32)
    if sink is not None:
        sink_col = jnp.broadcast_to(sink.astype(jnp.float32).reshape(hk, g, 1, 1), (b, hk, g, lc, 1))
        s = jnp.concatenate([s, sink_col], axis=-1)
    p = jax.nn.softmax(s, axis=-1)[..., :lc].astype(v.dtype)
    o = jnp.einsum('bkgqm,bmkd->bqkgd', p, v)
    return o.reshape(b, lc, hq * d)


def na_column_layout():
    nj = GRID_W // NA_KW
    kb = 2 * NA_KW
    starts = np.clip(np.arange(nj) * NA_KW - NA_KW // 2, 0, GRID_W - kb)
    key_col = starts[:, None] + np.arange(kb)[None, :]
    q_col = np.arange(nj)[:, None] * NA_KW + np.arange(NA_KW)[None, :]
    win = np.clip(q_col - NA_KW // 2, 0, GRID_W - NA_KW)
    kc3 = key_col[:, None, :]
    valid = (kc3 >= win[..., None]) & (kc3 < win[..., None] + NA_KW)
    col_off = np.clip(kc3 - q_col[..., None] + NA_KW - 1, 0, 2 * NA_KW - 2)
    return key_col, valid, col_off


def neighbourhood_attention(q, k, v, kc, vc, rpb):
    b, L, h, d = q.shape
    rows = L // GRID_W
    kh = min(NA_KH, rows)
    key_col, col_valid, col_off = na_column_layout()
    nj, kb = key_col.shape
    grid = lambda t: t.reshape(b, rows, GRID_W, h, d).transpose(0, 3, 1, 2, 4)
    qg, kg, vg = grid(q), grid(k), grid(v)
    kct, vct = kc.transpose(0, 2, 1, 3), vc.transpose(0, 2, 1, 3)
    valid = jnp.asarray(np.broadcast_to(col_valid[:, :, None, :], (nj, NA_KW, kh, kb)).reshape(nj, NA_KW, kh * kb))
    rpb_cols = rpb[:, :, col_off]
    n_loc = kh * kb

    def row_block(r):
        rs = jnp.clip(r - kh // 2, 0, rows - kh)
        q_r = lax.dynamic_index_in_dim(qg, r, axis=2, keepdims=False).reshape(b, h, nj, NA_KW, d)

        def gather(t):
            t = lax.dynamic_slice_in_dim(t, rs, kh, axis=2)[:, :, :, key_col]
            return t.transpose(0, 1, 3, 2, 4, 5).reshape(b, h, nj, n_loc, d)

        k_r, v_r = gather(kg), gather(vg)
        row_off = rs - r + (NA_KH - 1) + jnp.arange(kh)
        bias = rpb_cols[:, row_off].transpose(0, 2, 3, 1, 4).reshape(h, nj, NA_KW, n_loc)
        s_loc = jnp.einsum('bhjqd,bhjkd->bhjqk', q_r, k_r).astype(jnp.float32) + bias.astype(jnp.float32)
        s_loc = jnp.where(valid, s_loc, NEG_INF)
        s_ctx = jnp.einsum('bhjqd,bhkd->bhjqk', q_r, kct).astype(jnp.float32)
        p = jax.nn.softmax(jnp.concatenate([s_loc, s_ctx], axis=-1), axis=-1).astype(v.dtype)
        o = (jnp.einsum('bhjqk,bhjkd->bhjqd', p[..., :n_loc], v_r)
             + jnp.einsum('bhjqk,bhkd->bhjqd', p[..., n_loc:], vct))
        return o.reshape(b, h, GRID_W, d)

    o = lax.map(row_block, jnp.arange(rows))
    return o.transpose(1, 0, 3, 2, 4).reshape(b, L, h * d)


def windowed_sink_attention(q, k, v, kc, vc, sink):
    b, L, hq, d = q.shape
    hk = k.shape[2]
    g = hq // hk
    lc = kc.shape[1]
    nb = L // SWA_BLOCK
    band = SWA_BLOCK + 2 * SWA_WINDOW
    qg = q.reshape(b, L, hk, g, d).transpose(0, 2, 3, 1, 4)
    pad = lambda t: jnp.pad(t.transpose(0, 2, 1, 3), ((0, 0), (0, 0), (SWA_WINDOW, SWA_WINDOW), (0, 0)))
    kp, vp = pad(k), pad(v)
    kct, vct = kc.transpose(0, 2, 1, 3), vc.transpose(0, 2, 1, 3)
    sink_col = jnp.broadcast_to(sink.astype(jnp.float32).reshape(hk, g, 1, 1), (b, hk, g, SWA_BLOCK, 1))
    qq = np.arange(SWA_BLOCK)[:, None]
    kk = np.arange(band)[None, :]
    in_window = np.abs(qq - (kk - SWA_WINDOW)) <= SWA_WINDOW

    def block(i):
        q_b = lax.dynamic_slice_in_dim(qg, i * SWA_BLOCK, SWA_BLOCK, axis=3)
        k_b = lax.dynamic_slice_in_dim(kp, i * SWA_BLOCK, band, axis=2)
        v_b = lax.dynamic_slice_in_dim(vp, i * SWA_BLOCK, band, axis=2)
        key_pos = i * SWA_BLOCK - SWA_WINDOW + jnp.arange(band)
        valid = in_window & (key_pos >= 0) & (key_pos < L)
        s = jnp.einsum('bkgqd,bkmd->bkgqm', q_b, k_b).astype(jnp.float32)
        s = jnp.where(valid, s, NEG_INF)
        s_ctx = jnp.einsum('bkgqd,bkmd->bkgqm', q_b, kct).astype(jnp.float32)
        p = jax.nn.softmax(jnp.concatenate([s, s_ctx, sink_col], axis=-1), axis=-1).astype(v.dtype)
        return (jnp.einsum('bkgqm,bkmd->bkgqd', p[..., :band], v_b)
                + jnp.einsum('bkgqm,bkmd->bkgqd', p[..., band:band + lc], vct))

    o = lax.map(block, jnp.arange(nb))
    return o.transpose(1, 0, 4, 2, 3, 5).reshape(b, L, hq * d)


def retention_na_mixer(hx, hc, w_in, w_out, ret_decay, ret_gn, na_rpb, cos, sin, need_ctx):
    cuts = [RET_W, 2 * RET_W, 3 * RET_W, 4 * RET_W, 4 * RET_W + NA_W, 4 * RET_W + 2 * NA_W]
    rq, rk, rv, rg, nq, nk, nv = jnp.split(hx @ w_in, cuts, axis=-1)
    crq, crk, crv, crg, cnq, cnk, cnv = jnp.split(hc @ w_in, cuts, axis=-1)
    scale = HEAD_DIM ** -0.5
    f32 = lambda t: t.transpose(0, 2, 1, 3).astype(jnp.float32)
    flip = lambda t: t[:, :, ::-1]
    log_gamma = jnp.log1p(-jnp.exp2(-ret_decay.astype(jnp.float32)))
    q = f32(apply_rope(split_heads(rq, RET_HEADS), cos, sin))
    k = f32(apply_rope(split_heads(rk, RET_HEADS), cos, sin)) * scale
    v = f32(split_heads(rv, RET_HEADS))
    cq = f32(split_heads(crq, RET_HEADS))
    ck = f32(split_heads(crk, RET_HEADS)) * scale
    cv = f32(split_heads(crv, RET_HEADS))
    zero = jnp.zeros((hx.shape[0], RET_HEADS, HEAD_DIM, HEAD_DIM), jnp.float32)
    c_f, st_f = retention_scan(cq, ck, cv, log_gamma[0], zero)
    c_b, st_b = retention_scan(flip(cq), flip(ck), flip(cv), log_gamma[1], zero)
    l_f, _ = retention_scan(q, k, v, log_gamma[0], st_f)
    l_b, _ = retention_scan(flip(q), flip(k), flip(v), log_gamma[1], st_b)
    ret_x = retention_readout(l_f + flip(l_b), rg, ret_gn)
    cnk_h, cnv_h = split_heads(cnk, NA_HEADS), split_heads(cnv, NA_HEADS)
    na_x = neighbourhood_attention(split_heads(nq, NA_HEADS) * scale, split_heads(nk, NA_HEADS),
                                   split_heads(nv, NA_HEADS), cnk_h, cnv_h, na_rpb)
    out_x = jnp.concatenate([ret_x, na_x], axis=-1) @ w_out
    out_c = None
    if need_ctx:
        ret_c = retention_readout(c_f + flip(c_b), crg, ret_gn)
        na_c = context_attention(split_heads(cnq, NA_HEADS) * scale, cnk_h, cnv_h)
        out_c = jnp.concatenate([ret_c, na_c], axis=-1) @ w_out
    return out_x, out_c


def swa_mixer(hx, hc, w_in, w_out, sink, cos, sin, need_ctx):
    cuts = [SWA_HEADS * HEAD_DIM, (SWA_HEADS + SWA_KV_HEADS) * HEAD_DIM]
    q, k, v = jnp.split(hx @ w_in, cuts, axis=-1)
    cq, ck, cv = jnp.split(hc @ w_in, cuts, axis=-1)
    scale = HEAD_DIM ** -0.5
    q = apply_rope(split_heads(q, SWA_HEADS), cos, sin) * scale
    k = apply_rope(split_heads(k, SWA_KV_HEADS), cos, sin)
    v = split_heads(v, SWA_KV_HEADS)
    ck, cv = split_heads(ck, SWA_KV_HEADS), split_heads(cv, SWA_KV_HEADS)
    out_x = windowed_sink_attention(q, k, v, ck, cv, sink) @ w_out
    out_c = None
    if need_ctx:
        out_c = context_attention(split_heads(cq, SWA_HEADS) * scale, ck, cv, sink) @ w_out
    return out_x, out_c


def grouped_expert_mlp(h, expert, weight, w_gu, w_down):
    n, d = h.shape
    a = expert.size
    e_flat = expert.reshape(-1)
    tok = jnp.arange(a, dtype=jnp.int32) // MOE_TOPK
    order = jnp.argsort(e_flat)
    e_sorted = e_flat[order]
    counts = jnp.bincount(e_flat, length=MOE_EXPERTS)
    padded = (counts + MOE_BLOCK - 1) // MOE_BLOCK * MOE_BLOCK
    ends = jnp.cumsum(padded)
    dest = (ends - padded)[e_sorted] + jnp.arange(a) - (jnp.cumsum(counts) - counts)[e_sorted]
    n_blocks = (a + MOE_EXPERTS * (MOE_BLOCK - 1) + MOE_BLOCK - 1) // MOE_BLOCK
    slot_tok = jnp.full((n_blocks * MOE_BLOCK,), n, jnp.int32).at[dest].set(tok[order])
    slot_w = jnp.zeros((n_blocks * MOE_BLOCK,), h.dtype).at[dest].set(weight.reshape(-1)[order])
    block_e = jnp.minimum(jnp.searchsorted(ends, jnp.arange(n_blocks) * MOE_BLOCK, side='right'), MOE_EXPERTS - 1)
    h_pad = jnp.concatenate([h, jnp.zeros((1, d), h.dtype)], axis=0)

    def expert_block(args):
        idx, e = args
        gate, up = jnp.split(h_pad[idx] @ w_gu[e], 2, axis=-1)
        return (jax.nn.silu(gate) * up) @ w_down[e]

    y = lax.map(expert_block, (slot_tok.reshape(n_blocks, MOE_BLOCK), block_e))
    y = y.reshape(-1, d) * slot_w[:, None]
    return jnp.zeros((n + 1, d), y.dtype).at[slot_tok].add(y)[:n]


def hierarchical_moe(h, wg, bg, we, be, w_gu, w_down):
    hf = h.astype(jnp.float32)
    pg = jax.nn.softmax(hf @ wg.astype(jnp.float32) + bg.astype(jnp.float32), axis=-1)
    gi = jnp.argmax(pg, axis=-1)
    gw = jnp.max(pg, axis=-1, keepdims=True)
    le = (hf @ we.astype(jnp.float32) + be.astype(jnp.float32)).reshape(-1, MOE_GROUPS, MOE_EPG)
    le = jnp.einsum('ng,nge->ne', jax.nn.one_hot(gi, MOE_GROUPS, dtype=jnp.float32), le)
    tw, ti = lax.top_k(jax.nn.softmax(le, axis=-1), MOE_TOPK)
    tw = tw / jnp.sum(tw, axis=-1, keepdims=True)
    weight = (gw * tw).astype(h.dtype)
    expert = gi[:, None].astype(jnp.int32) * MOE_EPG + ti
    return grouped_expert_mlp(h, expert, weight, w_gu, w_down)


def setup_inputs(seed: int = 0) -> dict:
    key = jax.random.key(seed)
    ks = jax.random.split(key, 22)
    d = D_MODEL
    n_even, n_odd = (DEPTH + 1) // 2, DEPTH // 2
    nrm = lambda k, shape, s: jax.random.normal(k, shape, jnp.float32) * s
    decay = RET_DECAY_BASE + jnp.arange(RET_HEADS, dtype=jnp.float32)
    return {
        'x': nrm(ks[0], (BATCH, SEQ, d), 1.0),
        'c': nrm(ks[1], (BATCH, d), 1.0),
        'ctx': nrm(ks[2], (BATCH, CTX_LEN, d), 1.0),
        'c_ctx': nrm(ks[3], (d,), 1.0),
        'ada_w': nrm(ks[4], (DEPTH, d, 6 * d), 0.5 * d ** -0.5),
        'ada_b': nrm(ks[5], (DEPTH, 6 * d), 0.02),
        'norm_g': 1.0 + nrm(ks[6], (DEPTH, 2, d), 0.02),
        'final_g': 1.0 + nrm(ks[7], (d,), 0.02),
        'ab_w_in': nrm(ks[8], (n_even, d, AB_IN), d ** -0.5),
        'ab_w_out': nrm(ks[9], (n_even, MIX_W, d), MIX_W ** -0.5),
        'ret_decay': decay + nrm(ks[10], (n_even, 2, RET_HEADS), 0.1),
        'ret_gn': 1.0 + nrm(ks[11], (n_even, RET_W), 0.02),
        'na_rpb': nrm(ks[12], (n_even, NA_HEADS, 2 * NA_KH - 1, 2 * NA_KW - 1), 0.1),
        'swa_w_in': nrm(ks[13], (n_odd, d, SWA_IN), d ** -0.5),
        'swa_w_out': nrm(ks[14], (n_odd, SWA_HEADS * HEAD_DIM, d), (SWA_HEADS * HEAD_DIM) ** -0.5),
        'swa_sink': nrm(ks[15], (n_odd, SWA_HEADS), 0.5),
        'router_g_w': nrm(ks[16], (DEPTH, d, MOE_GROUPS), d ** -0.5),
        'router_g_b': nrm(ks[17], (DEPTH, MOE_GROUPS), 0.01),
        'router_e_w': nrm(ks[18], (DEPTH, d, MOE_EXPERTS), d ** -0.5),
        'router_e_b': nrm(ks[19], (DEPTH, MOE_EXPERTS), 0.01),
        'expert_w_gu': nrm(ks[20], (DEPTH, MOE_EXPERTS, d, 2 * MOE_FF), d ** -0.5),
        'expert_w_down': nrm(ks[21], (DEPTH, MOE_EXPERTS, MOE_FF, d), MOE_FF ** -0.5),
    }


def reference(x, c, ctx, c_ctx, ada_w, ada_b, norm_g, final_g, ab_w_in, ab_w_out, ret_decay, ret_gn,
              na_rpb, swa_w_in, swa_w_out, swa_sink, router_g_w, router_g_b, router_e_w, router_e_b,
              expert_w_gu, expert_w_down):
    L = x.shape[1]
    cos, sin = axial_rope_tables(L)
    s_c = jax.nn.silu(c)
    s_cc = jax.nn.silu(c_ctx)
    xc = ctx
    for layer in range(DEPTH):
        last = layer == DEPTH - 1
        sh1, sc1, g1, sh2, sc2, g2 = jnp.split((s_c @ ada_w[layer] + ada_b[layer])[:, None, :], 6, axis=-1)
        csh1, csc1, cg1, csh2, csc2, cg2 = jnp.split((s_cc @ ada_w[layer] + ada_b[layer])[None, None, :], 6, axis=-1)
        hx = modulate(rms_norm(x, norm_g[layer, 0]), sh1, sc1)
        hc = modulate(rms_norm(xc, norm_g[layer, 0]), csh1, csc1)
        if layer % 2 == 0:
            j = layer // 2
            ox, oc = retention_na_mixer(hx, hc, ab_w_in[j], ab_w_out[j], ret_decay[j], ret_gn[j], na_rpb[j],
                                        cos, sin, not last)
        else:
            j = layer // 2
            ox, oc = swa_mixer(hx, hc, swa_w_in[j], swa_w_out[j], swa_sink[j], cos, sin, not last)
        x = x + g1 * ox
        hx = modulate(rms_norm(x, norm_g[layer, 1]), sh2, sc2).reshape(-1, D_MODEL)
        moe_w = (router_g_w[layer], router_g_b[layer], router_e_w[layer], router_e_b[layer],
                 expert_w_gu[layer], expert_w_down[layer])
        if last:
            x = x + g2 * hierarchical_moe(hx, *moe_w).reshape(x.shape)
        else:
            xc = xc + cg1 * oc
            hc = modulate(rms_norm(xc, norm_g[layer, 1]), csh2, csc2).reshape(-1, D_MODEL)
            y = hierarchical_moe(jnp.concatenate([hx, hc], axis=0), *moe_w)
            n_lat = hx.shape[0]
            x = x + g2 * y[:n_lat].reshape(x.shape)
            xc = xc + cg2 * y[n_lat:].reshape(xc.shape)
    return rms_norm(x, final_g)
```

```cpp
#include <hip/hip_runtime.h>
#include <cstdio>
#include <cstdint>

#define LAS __attribute__((address_space(3)))
typedef unsigned short bf16_t;
typedef float f32x4 __attribute__((ext_vector_type(4)));
typedef unsigned u32x4 __attribute__((ext_vector_type(4)));
typedef unsigned u32x2 __attribute__((ext_vector_type(2)));

constexpr int D = 1024, NB = 16, SEQ = 2048, CTXL = 256, GW = 64;
constexpr int NL = NB * SEQ, NC = NB * CTXL, NTOK = NL + NC;
constexpr int ABIN = 3584, SWAIN = 1536, FF = 512, NEXP = 32;
constexpr int NTHREADS = 512, NWAVES = 8;
constexpr int MAXSLOT = 81920;
constexpr float LOG2E = 1.4426950408889634f;

constexpr size_t MiB = 1u << 20;
constexpr size_t WS_CTL = 0;
constexpr size_t WS_MOD = 1 * MiB;
constexpr size_t WS_ROPE = 2 * MiB;
constexpr size_t WS_ROUTE = 2 * MiB + 65536;
constexpr size_t WS_WIN0 = 4 * MiB;
constexpr size_t WS_WOUT0 = 12 * MiB;
constexpr size_t WS_WIN1 = 14 * MiB;
constexpr size_t WS_WOUT1 = 18 * MiB;
constexpr size_t WS_WGU = 20 * MiB;
constexpr size_t WS_WDN = 148 * MiB;
constexpr size_t WS_XC = 212 * MiB;
constexpr size_t WS_H = 228 * MiB;
constexpr size_t WS_MIX = 300 * MiB;
constexpr size_t WS_QKV = 372 * MiB;
constexpr size_t WS_HS = WS_QKV;
constexpr size_t WS_ACT = WS_QKV + 160 * MiB;
constexpr size_t WS_Y = 624 * MiB;
constexpr size_t WS_END = 784 * MiB;
constexpr size_t RT_TOKE = 0;
constexpr size_t RT_TOKW = RT_TOKE + (size_t)NTOK * 8;
constexpr size_t RT_TOKR = RT_TOKW + (size_t)NTOK * 8;
constexpr size_t RT_TOKS = RT_TOKR + (size_t)NTOK * 8;
constexpr size_t RT_BCNT = RT_TOKS + (size_t)NTOK * 8;
constexpr size_t RT_TILEE = RT_BCNT + 256 * 32 * 4;
constexpr size_t RT_END = RT_TILEE + 324 * 4;
static_assert(WS_ROUTE + RT_END <= WS_WIN0, "route arrays");

__device__ __forceinline__ float bf2f(unsigned v) { return __uint_as_float(v << 16); }
__device__ __forceinline__ unsigned f2bf(float f) { unsigned u = __float_as_uint(f); return (u + 0x7fffu + ((u >> 16) & 1u)) >> 16; }
__device__ __forceinline__ unsigned pk2(float lo, float hi) { return f2bf(lo) | (f2bf(hi) << 16); }
__device__ __forceinline__ float wave_sum(float v) {
#pragma unroll
    for (int o = 1; o < 64; o <<= 1) v += __shfl_xor(v, o);
    return v;
}
__device__ __forceinline__ float silu_f(float v) { return v / (1.f + __expf(-v)); }
__device__ __forceinline__ void unpack8(const u32x4 w, float* f) {
    f[0] = bf2f(w.x & 0xffffu); f[1] = bf2f(w.x >> 16); f[2] = bf2f(w.y & 0xffffu); f[3] = bf2f(w.y >> 16);
    f[4] = bf2f(w.z & 0xffffu); f[5] = bf2f(w.z >> 16); f[6] = bf2f(w.w & 0xffffu); f[7] = bf2f(w.w >> 16);
}

struct Args { const float* in[22]; float* out; unsigned char* ws; int ph_lo, ph_hi; };
enum { I_X = 0, I_C, I_CTX, I_CCTX, I_ADAW, I_ADAB, I_NORMG, I_FINALG, I_ABWIN, I_ABWOUT, I_RETDEC, I_RETGN, I_RPB, I_SWAWIN, I_SWAWOUT, I_SINK,
       I_RGW, I_RGB, I_REW, I_REB, I_WGU, I_WDN };

struct Ctx {
    const float* in[22]; float* out; unsigned char* ws;
    LAS unsigned char* lds;
    int tid, lane, wave, blk, nblk;
};

__device__ __forceinline__ void transpose_item(const float* W, int K, int N, bf16_t* WT, int k0, int n0, int drow0, LAS float* scr, int lane) {
#pragma unroll 8
    for (int i = 0; i < 32; ++i) { const int kk = 2 * i + (lane >> 5); scr[kk * 33 + (lane & 31)] = W[(size_t)(k0 + kk) * N + n0 + (lane & 31)]; }
    asm volatile("s_waitcnt lgkmcnt(0)" ::: "memory");
    const int c = lane & 7;
#pragma unroll
    for (int j = 0; j < 4; ++j) { const int n = (lane >> 3) + 8 * j; const LAS float* s = scr + (8 * c) * 33 + n;
        u32x4 o; o.x = pk2(s[0 * 33], s[1 * 33]); o.y = pk2(s[2 * 33], s[3 * 33]); o.z = pk2(s[4 * 33], s[5 * 33]); o.w = pk2(s[6 * 33], s[7 * 33]);
        *(u32x4*)(WT + (size_t)(drow0 + n) * K + k0 + 8 * c) = o; }
    asm volatile("s_waitcnt lgkmcnt(0)" ::: "memory");
}
__device__ __forceinline__ int gu_row(int n) { const int u = n >= 512, g = n & 511; return 256 * (g >> 7) + 128 * u + (g & 127); }

__device__ __forceinline__ void phase_prep(Ctx& F) {
    if (F.blk < 192) {
        const int l = F.blk / 96, col0 = (F.blk % 96) * 64;
        LAS float* s = (LAS float*)F.lds;
        LAS float* red = (LAS float*)(F.lds + 17 * 1024 * 4);
        for (int idx = F.tid; idx < 17 * 1024; idx += NTHREADS) { const int r = idx >> 10, k = idx & 1023; const float v = r < 16 ? F.in[I_C][r * 1024 + k] : F.in[I_CCTX][k]; s[idx] = silu_f(v); }
        __syncthreads();
        float acc[17];
#pragma unroll
        for (int r = 0; r < 17; ++r) acc[r] = 0.f;
        const float* wp = F.in[I_ADAW] + ((size_t)l * 1024 + F.wave * 128) * 6144 + col0 + F.lane;
#pragma unroll 4
        for (int k = 0; k < 128; ++k) { const float wv = wp[(size_t)k * 6144];
#pragma unroll
            for (int r = 0; r < 17; ++r) acc[r] += s[r * 1024 + F.wave * 128 + k] * wv; }
#pragma unroll
        for (int r = 0; r < 17; ++r) red[(F.wave * 17 + r) * 64 + F.lane] = acc[r];
        __syncthreads();
        float* mod = (float*)(F.ws + WS_MOD);
        for (int idx = F.tid; idx < 17 * 64; idx += NTHREADS) { const int r = idx >> 6, cl = idx & 63; float v = F.in[I_ADAB][l * 6144 + col0 + cl];
#pragma unroll
            for (int w = 0; w < 8; ++w) v += red[(w * 17 + r) * 64 + cl];
            mod[(size_t)(l * 17 + r) * 6144 + col0 + cl] = v; }
        __syncthreads();
    }
    if (F.blk == F.nblk - 1) {
        float* rt = (float*)(F.ws + WS_ROPE);
        for (int idx = F.tid; idx < 1024; idx += NTHREADS) { const int pos = idx >> 4, f = idx & 15;
            const float inv = exp2f(-(float)f * (13.287712379549449f / 16.f));
            const float ang = (float)pos * inv; const double rev = (double)ang * 0.15915494309189535; const float fr = (float)(rev - floor(rev));
            rt[idx * 2] = __builtin_amdgcn_cosf(fr); rt[idx * 2 + 1] = __builtin_amdgcn_sinf(fr); }
    }
    LAS float* scr = (LAS float*)(F.lds + F.wave * 16384);
    const int gw = F.blk * NWAVES + F.wave, NGW = F.nblk * NWAVES;
    constexpr int I0 = 16 * 112, I1 = 16 * 32, I2 = 16 * 48, I3 = 16 * 32, I4 = 64 * 16 * 32, I5 = 64 * 8 * 32;
    for (int it = gw; it < I0 + I1 + I2 + I3 + I4 + I5; it += NGW) {
        int r = it;
        if (r < I0) { transpose_item(F.in[I_ABWIN], 1024, ABIN, (bf16_t*)(F.ws + WS_WIN0), 64 * (r / 112), 32 * (r % 112), 32 * (r % 112), scr, F.lane); continue; } r -= I0;
        if (r < I1) { transpose_item(F.in[I_ABWOUT], 1024, 1024, (bf16_t*)(F.ws + WS_WOUT0), 64 * (r / 32), 32 * (r % 32), 32 * (r % 32), scr, F.lane); continue; } r -= I1;
        if (r < I2) { transpose_item(F.in[I_SWAWIN], 1024, SWAIN, (bf16_t*)(F.ws + WS_WIN1), 64 * (r / 48), 32 * (r % 48), 32 * (r % 48), scr, F.lane); continue; } r -= I2;
        if (r < I3) { transpose_item(F.in[I_SWAWOUT], 1024, 1024, (bf16_t*)(F.ws + WS_WOUT1), 64 * (r / 32), 32 * (r % 32), 32 * (r % 32), scr, F.lane); continue; } r -= I3;
        if (r < I4) { const int e = r / 512, q = r % 512, n0 = 32 * (q % 32);
            transpose_item(F.in[I_WGU] + (size_t)e * 1024 * 1024, 1024, 1024, (bf16_t*)(F.ws + WS_WGU) + (size_t)e * 1024 * 1024, 64 * (q / 32), n0, gu_row(n0), scr, F.lane); continue; } r -= I4;
        { const int e = r / 256, q = r % 256, n0 = 32 * (q % 32);
            transpose_item(F.in[I_WDN] + (size_t)e * 512 * 1024, 512, 1024, (bf16_t*)(F.ws + WS_WDN) + (size_t)e * 1024 * 512, 64 * (q / 32), n0, n0, scr, F.lane); }
    }
}

struct RowMod { float a[16], s[16]; };
__device__ __forceinline__ void load_rowmod(const Ctx& F, int l, int which, int b, RowMod& M) {
    const float* mod = (const float*)(F.ws + WS_MOD) + (size_t)(l * 17 + b) * 6144;
    const float* g = F.in[I_NORMG] + (size_t)(l * 2 + which) * 1024;
#pragma unroll
    for (int j = 0; j < 4; ++j) { const int c = 4 * F.lane + 256 * j;
        const f32x4 gv = *(const f32x4*)(g + c), sh = *(const f32x4*)(mod + which * 3072 + c), sc = *(const f32x4*)(mod + which * 3072 + 1024 + c);
#pragma unroll
        for (int i = 0; i < 4; ++i) { M.a[4 * j + i] = gv[i] * (1.f + sc[i]); M.s[4 * j + i] = sh[i]; } }
}
__device__ __forceinline__ void load_row16(const float* p, int lane, float* v) {
#pragma unroll
    for (int j = 0; j < 4; ++j) { const f32x4 t = *(const f32x4*)(p + 4 * lane + 256 * j); v[4 * j] = t[0]; v[4 * j + 1] = t[1]; v[4 * j + 2] = t[2]; v[4 * j + 3] = t[3]; }
}
__device__ __forceinline__ void store_row16_bf16(bf16_t* p, int lane, const float* v) {
#pragma unroll
    for (int j = 0; j < 4; ++j) { u32x2 w; w.x = pk2(v[4 * j], v[4 * j + 1]); w.y = pk2(v[4 * j + 2], v[4 * j + 3]); *(u32x2*)(p + 4 * lane + 256 * j) = w; }
}
__device__ __forceinline__ void store_row16_f32(float* p, int lane, const float* v) {
#pragma unroll
    for (int j = 0; j < 4; ++j) { f32x4 t = {v[4 * j], v[4 * j + 1], v[4 * j + 2], v[4 * j + 3]}; *(f32x4*)(p + 4 * lane + 256 * j) = t; }
}
__device__ __forceinline__ float row_rstd(const float* v) {
    float ss = 0.f;
#pragma unroll
    for (int i = 0; i < 16; ++i) ss += v[i] * v[i];
    return rsqrtf(wave_sum(ss) * (1.f / 1024.f) + 1e-6f);
}

__device__ __forceinline__ void phase_norm0(Ctx& F) {
    bf16_t* H = (bf16_t*)(F.ws + WS_H);
    const int r0 = (F.blk * NWAVES + F.wave) * 18; int curb = -1; RowMod M;
    for (int row = r0; row < r0 + 18 && row < NTOK; ++row) {
        const int b = row < NL ? row >> 11 : 16;
        if (b != curb) { load_rowmod(F, 0, 0, b, M); curb = b; }
        const float* xp = row < NL ? F.in[I_X] + (size_t)row * D : F.in[I_CTX] + (size_t)(row - NL) * D;
        float v[16]; load_row16(xp, F.lane, v); const float rstd = row_rstd(v);
#pragma unroll
        for (int i = 0; i < 16; ++i) v[i] = v[i] * rstd * M.a[i] + M.s[i];
        store_row16_bf16(H + (size_t)row * D, F.lane, v);
    }
}

__device__ __forceinline__ void load_router_lds(Ctx& F, int l) {
    LAS float* W = (LAS float*)F.lds;
    const float* wg = F.in[I_RGW] + (size_t)l * 1024 * 4; const float* we = F.in[I_REW] + (size_t)l * 1024 * 32;
    for (int idx = F.tid; idx < 1024 * 36; idx += NTHREADS) { const int k = idx / 36, c = idx % 36; const int ln = (k >> 2) & 63, j = k >> 8, i = k & 3;
        W[((j * 4 + i) * 64 + ln) * 36 + c] = c < 4 ? wg[k * 4 + c] : we[k * 32 + c - 4]; }
    LAS int* cnt = (LAS int*)(F.lds + 1024 * 36 * 4);
    if (F.tid < 32) cnt[F.tid] = 0;
    __syncthreads();
}
__device__ __forceinline__ void phase_norm_router(Ctx& F, int l, int nrows) {
    load_router_lds(F, l);
    LAS float* W = (LAS float*)F.lds; LAS int* cnt = (LAS int*)(F.lds + 1024 * 36 * 4);
    bf16_t* H = (bf16_t*)(F.ws + WS_H);
    int* tok_e = (int*)(F.ws + WS_ROUTE + RT_TOKE); float* tok_w = (float*)(F.ws + WS_ROUTE + RT_TOKW); int* tok_r = (int*)(F.ws + WS_ROUTE + RT_TOKR);
    const float* bgp = F.in[I_RGB] + l * 4; const float* bep = F.in[I_REB] + l * 32;
    const int r0 = (F.blk * NWAVES + F.wave) * 18; int curb = -1; RowMod M;
    for (int row = r0; row < r0 + 18 && row < nrows; ++row) {
        const int b = row < NL ? row >> 11 : 16;
        if (b != curb) { load_rowmod(F, l, 1, b, M); curb = b; }
        const float* xp = row < NL ? F.out + (size_t)row * D : (const float*)(F.ws + WS_XC) + (size_t)(row - NL) * D;
        float v[16]; load_row16(xp, F.lane, v); const float rstd = row_rstd(v);
#pragma unroll
        for (int i = 0; i < 16; ++i) v[i] = v[i] * rstd * M.a[i] + M.s[i];
        store_row16_bf16(H + (size_t)row * D, F.lane, v);
        float lg[36];
#pragma unroll
        for (int c = 0; c < 36; ++c) lg[c] = 0.f;
#pragma unroll
        for (int q = 0; q < 16; ++q) { const LAS float* wr = W + ((size_t)q * 64 + F.lane) * 36;
#pragma unroll
            for (int c4 = 0; c4 < 9; ++c4) { const f32x4 w4 = *(const LAS f32x4*)(wr + 4 * c4);
                lg[4 * c4] += v[q] * w4[0]; lg[4 * c4 + 1] += v[q] * w4[1]; lg[4 * c4 + 2] += v[q] * w4[2]; lg[4 * c4 + 3] += v[q] * w4[3]; }
            asm volatile("" ::: "memory"); }
#pragma unroll
        for (int c = 0; c < 36; ++c) lg[c] = wave_sum(lg[c]);
        float g0 = lg[0] + bgp[0], g1 = lg[1] + bgp[1], g2 = lg[2] + bgp[2], g3 = lg[3] + bgp[3];
        int gi = 0; float gm = g0; if (g1 > gm) { gm = g1; gi = 1; } if (g2 > gm) { gm = g2; gi = 2; } if (g3 > gm) { gm = g3; gi = 3; }
        const float gwt = 1.f / (__expf(g0 - gm) + __expf(g1 - gm) + __expf(g2 - gm) + __expf(g3 - gm));
        float le[8];
#pragma unroll
        for (int i = 0; i < 8; ++i) { le[i] = lg[4 + i] + bep[i];
            if (gi == 1) le[i] = lg[12 + i] + bep[8 + i]; if (gi == 2) le[i] = lg[20 + i] + bep[16 + i]; if (gi == 3) le[i] = lg[28 + i] + bep[24 + i]; }
        int i0 = 0; float v0 = le[0];
#pragma unroll
        for (int i = 1; i < 8; ++i) if (le[i] > v0) { v0 = le[i]; i0 = i; }
        int i1 = -1; float v1 = -3.0e38f;
#pragma unroll
        for (int i = 0; i < 8; ++i) if (i != i0 && le[i] > v1) { v1 = le[i]; i1 = i; }
        const float ex = __expf(v1 - v0), t0 = 1.f / (1.f + ex), t1 = ex * t0;
        if (F.lane == 0) {
            const int e0 = gi * 8 + i0, e1 = gi * 8 + i1;
            tok_e[row * 2] = e0; tok_e[row * 2 + 1] = e1; tok_w[row * 2] = gwt * t0; tok_w[row * 2 + 1] = gwt * t1;
            tok_r[row * 2] = atomicAdd((int*)&cnt[e0], 1); tok_r[row * 2 + 1] = atomicAdd((int*)&cnt[e1], 1);
        }
    }
    __syncthreads();
    if (F.tid < 32) ((int*)(F.ws + WS_ROUTE + RT_BCNT))[F.blk * 32 + F.tid] = cnt[F.tid];
}

__device__ __forceinline__ void phase_slots(Ctx& F, int nrows) {
    LAS int* base = (LAS int*)F.lds;
    const int* bc = (const int*)(F.ws + WS_ROUTE + RT_BCNT);
    if (F.tid < 32) { int tot = 0, below = 0; for (int b = 0; b < F.nblk; ++b) { const int c = bc[b * 32 + F.tid]; tot += c; if (b < F.blk) below += c; }
        base[64 + F.tid] = (tot + 255) & ~255; base[F.tid] = below; }
    __syncthreads();
    if (F.tid == 0) { int off = 0; for (int e = 0; e < 32; ++e) { const int p = base[64 + e]; base[32 + e] = off; base[e] += off; off += p; }
        base[96] = off; }
    __syncthreads();
    if (F.blk == 0) { int* te = (int*)(F.ws + WS_ROUTE + RT_TILEE); const int nt = base[96] >> 8;
        for (int t = F.tid; t < nt; t += NTHREADS) { int e = 0; for (int q = 1; q < 32; ++q) if (base[32 + q] <= t * 256) e = q; te[t] = e; }
        if (F.tid == 0) te[320] = nt; }
    const int* tok_e = (const int*)(F.ws + WS_ROUTE + RT_TOKE); const int* tok_r = (const int*)(F.ws + WS_ROUTE + RT_TOKR); int* tok_s = (int*)(F.ws + WS_ROUTE + RT_TOKS);
    const bf16_t* H = (const bf16_t*)(F.ws + WS_H); bf16_t* HS = (bf16_t*)(F.ws + WS_HS);
    const int r0 = (F.blk * NWAVES + F.wave) * 18;
    for (int row = r0; row < r0 + 18 && row < nrows; ++row) {
        const u32x4 a = *(const u32x4*)(H + (size_t)row * D + F.lane * 8), b = *(const u32x4*)(H + (size_t)row * D + 512 + F.lane * 8);
#pragma unroll
        for (int k = 0; k < 2; ++k) { const int s = base[tok_e[row * 2 + k]] + tok_r[row * 2 + k];
            *(u32x4*)(HS + (size_t)s * D + F.lane * 8) = a; *(u32x4*)(HS + (size_t)s * D + 512 + F.lane * 8) = b;
            if (F.lane == 0) tok_s[row * 2 + k] = s; }
    }
}

__device__ __forceinline__ void phase_combine(Ctx& F, int l) {
    const int nrows = l == 0 ? NTOK : NL;
    const int* tok_s = (const int*)(F.ws + WS_ROUTE + RT_TOKS); const float* tok_w = (const float*)(F.ws + WS_ROUTE + RT_TOKW);
    const bf16_t* Y = (const bf16_t*)(F.ws + WS_Y); bf16_t* H = (bf16_t*)(F.ws + WS_H);
    const float* mod = (const float*)(F.ws + WS_MOD);
    const int r0 = (F.blk * NWAVES + F.wave) * 18; int curb = -1; RowMod M; float g2[16];
    float fg[16];
    if (l == 1) load_row16(F.in[I_FINALG], F.lane, fg);
    for (int row = r0; row < r0 + 18 && row < nrows; ++row) {
        const int b = row < NL ? row >> 11 : 16;
        if (b != curb) { if (l == 0) load_rowmod(F, 1, 0, b, M); load_row16(mod + (size_t)(l * 17 + b) * 6144 + 5 * 1024, F.lane, g2); curb = b; }
        float* xp = row < NL ? F.out + (size_t)row * D : (float*)(F.ws + WS_XC) + (size_t)(row - NL) * D;
        float v[16]; load_row16(xp, F.lane, v);
        const int s0 = tok_s[row * 2], s1 = tok_s[row * 2 + 1]; const float w0 = tok_w[row * 2], w1 = tok_w[row * 2 + 1];
#pragma unroll
        for (int j = 0; j < 4; ++j) { const u32x2 a = *(const u32x2*)(Y + (size_t)s0 * D + 4 * F.lane + 256 * j), c = *(const u32x2*)(Y + (size_t)s1 * D + 4 * F.lane + 256 * j);
            const float y0 = w0 * bf2f(a.x & 0xffffu) + w1 * bf2f(c.x & 0xffffu), y1 = w0 * bf2f(a.x >> 16) + w1 * bf2f(c.x >> 16);
            const float y2 = w0 * bf2f(a.y & 0xffffu) + w1 * bf2f(c.y & 0xffffu), y3 = w0 * bf2f(a.y >> 16) + w1 * bf2f(c.y >> 16);
            v[4 * j] += g2[4 * j] * y0; v[4 * j + 1] += g2[4 * j + 1] * y1; v[4 * j + 2] += g2[4 * j + 2] * y2; v[4 * j + 3] += g2[4 * j + 3] * y3; }
        const float rstd = row_rstd(v);
        if (l == 0) {
            store_row16_f32(xp, F.lane, v);
#pragma unroll
            for (int i = 0; i < 16; ++i) v[i] = v[i] * rstd * M.a[i] + M.s[i];
            store_row16_bf16(H + (size_t)row * D, F.lane, v);
        } else {
#pragma unroll
            for (int i = 0; i < 16; ++i) v[i] = v[i] * rstd * fg[i];
            store_row16_f32(xp, F.lane, v);
        }
    }
}

struct GemmDesc { const bf16_t* A; int lda; const bf16_t* Bt; int K; int nM, nN; const int* tile_e; size_t estride; };

template <class Epi>
__device__ __forceinline__ void gemm_naive(Ctx& F, const GemmDesc g, const Epi& E) {
    const int wr = F.wave >> 2, wc = F.wave & 3, fr = F.lane & 15, fq = F.lane >> 4;
    const int nun = g.nM * g.nN;
    for (int u = F.blk; u < nun; u += F.nblk) {
        const int pm = u / g.nN, pn = u % g.nN;
        const bf16_t* Bt = g.Bt + (g.tile_e ? (size_t)g.tile_e[pm] * g.estride : 0);
        const bf16_t* bp = Bt + (size_t)(256 * pn + 32 * wc + 8 * fq) * g.K;
        for (int am = 0; am < 8; ++am) {
            const int ai = am >> 2, m = am & 3, row = 256 * pm + 128 * ai + 64 * wr + 16 * m + fr;
            const bf16_t* ap = g.A + (size_t)row * g.lda;
            float v0[8], v1[8];
#pragma unroll
            for (int i = 0; i < 8; ++i) { v0[i] = 0.f; v1[i] = 0.f; }
            for (int k0 = 0; k0 < g.K; k0 += 8) {
                float a[8]; unpack8(*(const u32x4*)(ap + k0), a);
#pragma unroll
                for (int i = 0; i < 8; ++i) { float b[8]; unpack8(*(const u32x4*)(bp + (size_t)i * g.K + k0), b);
#pragma unroll
                    for (int q = 0; q < 8; ++q) v0[i] += a[q] * b[q];
                    unpack8(*(const u32x4*)(bp + (size_t)(128 + i) * g.K + k0), b);
#pragma unroll
                    for (int q = 0; q < 8; ++q) v1[i] += a[q] * b[q]; }
            }
            E(row, pn, 32 * wc + 8 * fq, v0, v1);
        }
    }
}

__device__ __forceinline__ void store8_bf16(bf16_t* p, const float* v) { u32x4 w; w.x = pk2(v[0], v[1]); w.y = pk2(v[2], v[3]); w.z = pk2(v[4], v[5]); w.w = pk2(v[6], v[7]); *(u32x4*)p = w; }

__device__ __forceinline__ void rope8(float* v, int row, int colbase, const float* rt) {
    const int lane = threadIdx.x & 63, fq = lane >> 4;
    const int t = row & (SEQ - 1), axis = (colbase >> 5) & 1, pos = axis ? (t & 63) : (t >> 6);
    const bool x2 = fq >= 2; const int f0 = 8 * (fq & 1);
#pragma unroll
    for (int i = 0; i < 8; ++i) { const float p = __shfl_xor(v[i], 32); const float c = rt[(pos * 16 + f0 + i) * 2], s = rt[(pos * 16 + f0 + i) * 2 + 1];
        v[i] = x2 ? v[i] * c + p * s : v[i] * c - p * s; }
}
struct EpiIn0 { bf16_t* O; const float* rt;
    __device__ __forceinline__ void operator()(int row, int pn, int cl, float* v0, float* v1) const {
        const bool lat = row < NL;
        if (pn < 4) { if (lat) { rope8(v0, row, cl, rt); rope8(v1, row, cl + 128, rt); }
            if (pn >= 2) {
#pragma unroll
                for (int i = 0; i < 8; ++i) { v0[i] *= 0.125f; v1[i] *= 0.125f; } } }
        else if (pn == 8 || pn == 9) {
#pragma unroll
            for (int i = 0; i < 8; ++i) { v0[i] *= 0.125f * LOG2E; v1[i] *= 0.125f * LOG2E; } }
        bf16_t* p = O + (size_t)row * ABIN + 256 * pn + cl; store8_bf16(p, v0); store8_bf16(p + 128, v1);
    } };
struct EpiIn1 { bf16_t* O; const float* rt; int col0; int rowoff;
    __device__ __forceinline__ void operator()(int row, int pn, int cl, float* v0, float* v1) const {
        const int c = col0 + 256 * pn; row += rowoff;
        if (row < NL && c < 1280) { rope8(v0, row, cl, rt); rope8(v1, row, cl + 128, rt); }
        if (c < 1024) {
#pragma unroll
            for (int i = 0; i < 8; ++i) { v0[i] *= 0.125f * LOG2E; v1[i] *= 0.125f * LOG2E; } }
        bf16_t* p = O + (size_t)row * SWAIN + c + cl; store8_bf16(p, v0); store8_bf16(p + 128, v1);
    } };
struct EpiRes { const float* xl; const float* xc; float* ol; float* oc; const float* mod;
    __device__ __forceinline__ void operator()(int row, int pn, int cl, float* v0, float* v1) const {
        const int b = row < NL ? row >> 11 : 16; const float* g = mod + (size_t)b * 6144 + 2048 + 256 * pn + cl;
        const float* src = row < NL ? xl + (size_t)row * D : xc + (size_t)(row - NL) * D; float* dst = row < NL ? ol + (size_t)row * D : oc + (size_t)(row - NL) * D;
#pragma unroll
        for (int h = 0; h < 2; ++h) { float* v = h ? v1 : v0; const int c = 256 * pn + cl + 128 * h;
            const f32x4 g0 = *(const f32x4*)(g + 128 * h), g1 = *(const f32x4*)(g + 128 * h + 4), x0 = *(const f32x4*)(src + c), x1 = *(const f32x4*)(src + c + 4);
            f32x4 o0, o1;
#pragma unroll
            for (int i = 0; i < 4; ++i) { o0[i] = x0[i] + g0[i] * v[i]; o1[i] = x1[i] + g1[i] * v[4 + i]; }
            *(f32x4*)(dst + c) = o0; *(f32x4*)(dst + c + 4) = o1; }
    } };
struct EpiGU { bf16_t* O;
    __device__ __forceinline__ void operator()(int row, int pn, int cl, float* v0, float* v1) const {
        float a[8];
#pragma unroll
        for (int i = 0; i < 8; ++i) a[i] = silu_f(v0[i]) * v1[i];
        store8_bf16(O + (size_t)row * FF + 128 * pn + cl, a);
    } };
struct EpiY { bf16_t* O;
    __device__ __forceinline__ void operator()(int row, int pn, int cl, float* v0, float* v1) const {
        bf16_t* p = O + (size_t)row * D + 256 * pn + cl; store8_bf16(p, v0); store8_bf16(p + 128, v1);
    } };

__device__ __forceinline__ void load_vec64(const bf16_t* p, float* v) {
#pragma unroll
    for (int j = 0; j < 8; ++j) unpack8(*(const u32x4*)(p + 8 * j), v + 8 * j);
}
__device__ __forceinline__ float dot64(const float* q, const bf16_t* kp) {
    float s = 0.f;
#pragma unroll
    for (int j = 0; j < 8; ++j) { float k[8]; unpack8(*(const u32x4*)(kp + 8 * j), k);
#pragma unroll
        for (int i = 0; i < 8; ++i) s += q[8 * j + i] * k[i]; }
    return s;
}
__device__ __forceinline__ void axpy64(float* o, float al, float p, const bf16_t* vp) {
#pragma unroll
    for (int j = 0; j < 8; ++j) { float v[8]; unpack8(*(const u32x4*)(vp + 8 * j), v);
#pragma unroll
        for (int i = 0; i < 8; ++i) o[8 * j + i] = o[8 * j + i] * al + p * v[i]; }
}
__device__ __forceinline__ void attend(const float* q, float* o, float& m, float& l, const bf16_t* kp, const bf16_t* vp, float bias) {
    const float s = bias + dot64(q, kp);
    const float mn = fmaxf(m, s), al = exp2f(m - mn), p = exp2f(s - mn); l = l * al + p; m = mn;
    axpy64(o, al, p, vp);
}
__device__ __forceinline__ void store_vec64_scaled(bf16_t* p, const float* o, float sc) {
#pragma unroll
    for (int j = 0; j < 8; ++j) { float t[8];
#pragma unroll
        for (int i = 0; i < 8; ++i) t[i] = o[8 * j + i] * sc;
        store8_bf16(p + 8 * j, t); }
}
__device__ __forceinline__ void naive_retention(Ctx& F) {
    const bf16_t* QKV = (const bf16_t*)(F.ws + WS_QKV); bf16_t* MIX = (bf16_t*)(F.ws + WS_MIX);
    const int total = NB * 8 * 2304;
    for (int idx = F.blk * NTHREADS + F.tid; idx < total; idx += F.nblk * NTHREADS) {
        const int n = idx % 2304, bh = idx / 2304, h = bh & 7, b = bh >> 3;
        const float df = F.in[I_RETDEC][h], db = F.in[I_RETDEC][8 + h];
        const float lgf = log1pf(-exp2f(-df)) * LOG2E, lgb = log1pf(-exp2f(-db)) * LOG2E;
        const size_t rowc = (size_t)NL + b * CTXL, rowl = (size_t)b * SEQ;
        const size_t myrow = n < 256 ? rowc + n : rowl + (n - 256);
        float q[64], o[64]; load_vec64(QKV + myrow * ABIN + h * 64, q);
#pragma unroll
        for (int i = 0; i < 64; ++i) o[i] = 0.f;
        for (int m = 0; m < 2304; ++m) {
            float w = 0.f;
            if (n < 256) { if (m < 256) { if (m <= n) w += exp2f(lgf * (float)(n - m)); if (m >= n) w += exp2f(lgb * (float)(m - n)); } else continue; }
            else { const int t = n - 256;
                if (m < 256) w = exp2f(lgf * (float)(n - m)) + exp2f(lgb * (float)(2048 - t + m));
                else { const int t2 = m - 256; if (t2 <= t) w += exp2f(lgf * (float)(t - t2)); if (t2 >= t) w += exp2f(lgb * (float)(t2 - t)); } }
            const size_t r = m < 256 ? rowc + m : rowl + (m - 256);
            const float s = w * dot64(q, QKV + r * ABIN + 512 + h * 64);
            axpy64(o, 1.f, s, QKV + r * ABIN + 1024 + h * 64);
        }
        float mu = 0.f;
#pragma unroll
        for (int i = 0; i < 64; ++i) mu += o[i];
        mu *= (1.f / 64.f); float var = 0.f;
#pragma unroll
        for (int i = 0; i < 64; ++i) { o[i] -= mu; var += o[i] * o[i]; }
        const float rs = rsqrtf(var * (1.f / 64.f) + 1e-5f);
#pragma unroll
        for (int j = 0; j < 8; ++j) { float g[8], t[8]; unpack8(*(const u32x4*)(QKV + myrow * ABIN + 1536 + h * 64 + 8 * j), g);
#pragma unroll
            for (int i = 0; i < 8; ++i) t[i] = o[8 * j + i] * rs * F.in[I_RETGN][h * 64 + 8 * j + i] * silu_f(g[i]);
            store8_bf16(MIX + myrow * D + h * 64 + 8 * j, t); }
    }
}
__device__ __forceinline__ void naive_na(Ctx& F) {
    const bf16_t* QKV = (const bf16_t*)(F.ws + WS_QKV); bf16_t* MIX = (bf16_t*)(F.ws + WS_MIX);
    const int total = NB * 8 * 2304;
    for (int idx = F.blk * NTHREADS + F.tid; idx < total; idx += F.nblk * NTHREADS) {
        const int n = idx % 2304, bh = idx / 2304, h = bh & 7, b = bh >> 3;
        const size_t rowc = (size_t)NL + b * CTXL, rowl = (size_t)b * SEQ;
        const size_t myrow = n < 2048 ? rowl + n : rowc + (n - 2048);
        float q[64], o[64]; load_vec64(QKV + myrow * ABIN + 2048 + h * 64, q);
#pragma unroll
        for (int i = 0; i < 64; ++i) o[i] = 0.f;
        float m = -1e30f, l = 0.f;
        if (n < 2048) { const int r = n >> 6, c = n & 63; int rs = r - 4; rs = rs < 0 ? 0 : (rs > 24 ? 24 : rs); int win = c - 8; win = win < 0 ? 0 : (win > 48 ? 48 : win);
            const float* rpb = F.in[I_RPB] + (size_t)h * 15 * 31;
            for (int i = 0; i < 8; ++i) for (int j = 0; j < 16; ++j) { const int kr = rs + i, kc = win + j; const size_t kro = rowl + kr * 64 + kc;
                attend(q, o, m, l, QKV + kro * ABIN + 2560 + h * 64, QKV + kro * ABIN + 3072 + h * 64, rpb[(kr - r + 7) * 31 + (kc - c + 15)] * LOG2E); } }
        for (int j = 0; j < 256; ++j) { const size_t kro = rowc + j; attend(q, o, m, l, QKV + kro * ABIN + 2560 + h * 64, QKV + kro * ABIN + 3072 + h * 64, 0.f); }
        store_vec64_scaled(MIX + myrow * D + 512 + h * 64, o, 1.f / l);
    }
}
__device__ __forceinline__ void naive_swa(Ctx& F) {
    const bf16_t* QKV = (const bf16_t*)(F.ws + WS_QKV); bf16_t* MIX = (bf16_t*)(F.ws + WS_MIX);
    const int total = NB * 16 * 2048;
    for (int idx = F.blk * NTHREADS + F.tid; idx < total; idx += F.nblk * NTHREADS) {
        const int t = idx & 2047, bh = idx >> 11, h = bh & 15, b = bh >> 4, kv = h >> 2;
        const size_t rowc = (size_t)NL + b * CTXL, rowl = (size_t)b * SEQ;
        float q[64], o[64]; load_vec64(QKV + (rowl + t) * SWAIN + h * 64, q);
#pragma unroll
        for (int i = 0; i < 64; ++i) o[i] = 0.f;
        float m = F.in[I_SINK][h] * LOG2E, l = 1.f;
        const int lo = t - 128 < 0 ? 0 : t - 128, hi = t + 128 > 2047 ? 2047 : t + 128;
        for (int j = lo; j <= hi; ++j) attend(q, o, m, l, QKV + (rowl + j) * SWAIN + 1024 + kv * 64, QKV + (rowl + j) * SWAIN + 1280 + kv * 64, 0.f);
        for (int j = 0; j < 256; ++j) attend(q, o, m, l, QKV + (rowc + j) * SWAIN + 1024 + kv * 64, QKV + (rowc + j) * SWAIN + 1280 + kv * 64, 0.f);
        store_vec64_scaled(MIX + (rowl + t) * D + h * 64, o, 1.f / l);
    }
}

constexpr int LDS_BYTES = 150 * 1024;
constexpr int NPHASE = 18;
__global__ void __launch_bounds__(NTHREADS, 2) fwd_kernel(Args args) {
    extern __shared__ __attribute__((aligned(16))) unsigned char lds_raw[];
    Ctx F;
#pragma unroll
    for (int i = 0; i < 22; ++i) F.in[i] = args.in[i];
    F.out = args.out; F.ws = args.ws; F.lds = (LAS unsigned char*)lds_raw;
    F.tid = threadIdx.x; F.lane = F.tid & 63; F.wave = __builtin_amdgcn_readfirstlane(F.tid >> 6); F.blk = blockIdx.x; F.nblk = gridDim.x;
    const float* mod = (const float*)(F.ws + WS_MOD); const float* rt = (const float*)(F.ws + WS_ROPE);
    const int* tile_e = (const int*)(F.ws + WS_ROUTE + RT_TILEE);
    const int lo = args.ph_lo, hi = args.ph_hi;
#define PH(k) if (lo <= (k) && (k) < hi)
#define SEAM(k) do { __syncthreads(); } while (0)
    PH(0) { phase_prep(F); SEAM(0); }
    PH(1) { phase_norm0(F); SEAM(1); }
    PH(2) { { GemmDesc g{(const bf16_t*)(F.ws + WS_H), D, (const bf16_t*)(F.ws + WS_WIN0), D, NTOK / 256, ABIN / 256, nullptr, 0};
                  gemm_naive(F, g, EpiIn0{(bf16_t*)(F.ws + WS_QKV), rt}); } SEAM(2); }
    PH(3) { naive_retention(F); naive_na(F); SEAM(3); }
    PH(4) { { GemmDesc g{(const bf16_t*)(F.ws + WS_MIX), D, (const bf16_t*)(F.ws + WS_WOUT0), D, NTOK / 256, 4, nullptr, 0};
                  gemm_naive(F, g, EpiRes{F.in[I_X], F.in[I_CTX], F.out, (float*)(F.ws + WS_XC), mod}); } SEAM(4); }
    PH(5) { phase_norm_router(F, 0, NTOK); SEAM(5); }
    PH(6) { phase_slots(F, NTOK); SEAM(6); }
    PH(7) { { GemmDesc g{(const bf16_t*)(F.ws + WS_HS), D, (const bf16_t*)(F.ws + WS_WGU), D, tile_e[320], 4, tile_e, (size_t)1024 * 1024};
                  gemm_naive(F, g, EpiGU{(bf16_t*)(F.ws + WS_ACT)}); } SEAM(7); }
    PH(8) { { GemmDesc g{(const bf16_t*)(F.ws + WS_ACT), FF, (const bf16_t*)(F.ws + WS_WDN), FF, tile_e[320], 4, tile_e, (size_t)1024 * 512};
                  gemm_naive(F, g, EpiY{(bf16_t*)(F.ws + WS_Y)}); } SEAM(8); }
    PH(9) { phase_combine(F, 0); SEAM(9); }
    PH(10) { { GemmDesc g{(const bf16_t*)(F.ws + WS_H), D, (const bf16_t*)(F.ws + WS_WIN1), D, NL / 256, 6, nullptr, 0};
                   gemm_naive(F, g, EpiIn1{(bf16_t*)(F.ws + WS_QKV), rt, 0, 0});
                   GemmDesc g2{(const bf16_t*)(F.ws + WS_H) + (size_t)NL * D, D, (const bf16_t*)(F.ws + WS_WIN1) + (size_t)1024 * D, D, NC / 256, 2, nullptr, 0};
                   gemm_naive(F, g2, EpiIn1{(bf16_t*)(F.ws + WS_QKV), rt, 1024, NL}); } SEAM(10); }
    PH(11) { naive_swa(F); SEAM(11); }
    PH(12) { { GemmDesc g{(const bf16_t*)(F.ws + WS_MIX), D, (const bf16_t*)(F.ws + WS_WOUT1), D, NL / 256, 4, nullptr, 0};
                   gemm_naive(F, g, EpiRes{F.out, nullptr, F.out, nullptr, mod + 17 * 6144}); } SEAM(12); }
    PH(13) { phase_norm_router(F, 1, NL); SEAM(13); }
    PH(14) { phase_slots(F, NL); SEAM(14); }
    PH(15) { { GemmDesc g{(const bf16_t*)(F.ws + WS_HS), D, (const bf16_t*)(F.ws + WS_WGU) + (size_t)32 * 1024 * 1024, D, tile_e[320], 4, tile_e, (size_t)1024 * 1024};
                   gemm_naive(F, g, EpiGU{(bf16_t*)(F.ws + WS_ACT)}); } SEAM(15); }
    PH(16) { { GemmDesc g{(const bf16_t*)(F.ws + WS_ACT), FF, (const bf16_t*)(F.ws + WS_WDN) + (size_t)32 * 1024 * 512, FF, tile_e[320], 4, tile_e, (size_t)1024 * 512};
                   gemm_naive(F, g, EpiY{(bf16_t*)(F.ws + WS_Y)}); } SEAM(16); }
    PH(17) { phase_combine(F, 1); SEAM(17); }
#undef PH
#undef SEAM
}

extern "C" void kernel_launch(void* const* d_in, const int* in_sizes, int n_in, void* d_out, int out_size, void* d_ws, size_t ws_size, hipStream_t stream) {
    static int ready = 0;
    if (!ready) {
        if (n_in != 22 || out_size != NL * D || ws_size < WS_END) { fprintf(stderr, "kernel_launch: unexpected shapes (n_in %d out %d ws %zu)\n", n_in, out_size, ws_size); ready = -1; return; }
        if (hipFuncSetAttribute((const void*)fwd_kernel, hipFuncAttributeMaxDynamicSharedMemorySize, LDS_BYTES) != hipSuccess) { fprintf(stderr, "kernel_launch: hipFuncSetAttribute failed\n"); ready = -1; return; }
        ready = 1;
    }
    if (ready < 0) return;
    Args a{};
    for (int i = 0; i < 22; ++i) a.in[i] = (const float*)d_in[i];
    a.out = (float*)d_out; a.ws = (unsigned char*)d_ws;
    for (int ph = 0; ph < NPHASE; ++ph) { a.ph_lo = ph; a.ph_hi = ph + 1; hipLaunchKernelGGL(fwd_kernel, dim3(256), dim3(NTHREADS), LDS_BYTES, stream, a); }
}
```

```cpp
#include <hip/hip_runtime.h>
#include <hip/hip_cooperative_groups.h>
namespace cg = cooperative_groups;
#include <cstdio>
#include <cstdint>

#define LAS __attribute__((address_space(3)))
typedef unsigned short bf16_t;
typedef float f32x4 __attribute__((ext_vector_type(4)));
typedef unsigned u32x4 __attribute__((ext_vector_type(4)));
typedef unsigned u32x2 __attribute__((ext_vector_type(2)));
typedef short bf16x8 __attribute__((ext_vector_type(8)));

constexpr int D = 1024, NB = 16, SEQ = 2048, CTXL = 256, GW = 64;
constexpr int NL = NB * SEQ, NC = NB * CTXL, NTOK = NL + NC;
constexpr int ABIN = 3584, SWAIN = 1536, FF = 512, NEXP = 32;
constexpr int NTHREADS = 512, NWAVES = 8;
constexpr int MAXSLOT = 81920;
constexpr float LOG2E = 1.4426950408889634f;

constexpr size_t MiB = 1u << 20;
constexpr size_t WS_CTL = 0;
constexpr size_t WS_MOD = 1 * MiB;
constexpr size_t WS_ROPE = 2 * MiB;
constexpr size_t WS_RW = 2 * MiB + 16384;
constexpr size_t WS_ROUTE = 2 * MiB + 16384 + 393216;
constexpr size_t WS_WIN0 = 4 * MiB;
constexpr size_t WS_WOUT0 = 12 * MiB;
constexpr size_t WS_WIN1 = 14 * MiB;
constexpr size_t WS_WOUT1 = 18 * MiB;
constexpr size_t WS_WGU = 20 * MiB;
constexpr size_t WS_WDN = 148 * MiB;
constexpr size_t WS_STOK = 212 * MiB;
constexpr size_t WS_XC = 212 * MiB;
constexpr size_t WS_H = 228 * MiB;
constexpr size_t WS_MIX = 300 * MiB;
constexpr size_t WS_QKV = 372 * MiB;
constexpr size_t WS_HS = WS_QKV;
constexpr size_t WS_ACT = WS_QKV + 160 * MiB;
constexpr size_t WS_Y = 624 * MiB;
constexpr size_t WS_XB = 784 * MiB;
constexpr size_t WS_END = 856 * MiB;
constexpr size_t RT_TOKE = 0;
constexpr size_t RT_TOKW = RT_TOKE + (size_t)NTOK * 8;
constexpr size_t RT_TOKR = RT_TOKW + (size_t)NTOK * 8;
constexpr size_t RT_TOKS = RT_TOKR + (size_t)NTOK * 8;
constexpr size_t RT_BCNT = RT_TOKS + (size_t)NTOK * 8;
constexpr size_t RT_TILEE = RT_BCNT + 256 * 32 * 4;
constexpr size_t RT_CVEC = RT_TILEE + 324 * 4 + 16;
constexpr size_t RT_RSTD = RT_CVEC + 2 * 17 * 48 * 4;
constexpr size_t RT_END = RT_RSTD + (size_t)NTOK * 4;
static_assert(WS_ROUTE + RT_END <= WS_WIN0, "route arrays");

__device__ __forceinline__ float bf2f(unsigned v) { return __uint_as_float(v << 16); }
__device__ __forceinline__ unsigned f2bf(float f) { unsigned u = __float_as_uint(f); return (u + 0x7fffu + ((u >> 16) & 1u)) >> 16; }
__device__ __forceinline__ unsigned pk2(float lo, float hi) { typedef float f2_t __attribute__((ext_vector_type(2))); typedef __bf16 b2_t __attribute__((ext_vector_type(2)));
    f2_t v = {lo, hi}; b2_t b = __builtin_convertvector(v, b2_t); return __builtin_bit_cast(unsigned, b); }
__device__ __forceinline__ void store8_bf16(bf16_t* p, const float* v) { u32x4 w; w.x = pk2(v[0], v[1]); w.y = pk2(v[2], v[3]); w.z = pk2(v[4], v[5]); w.w = pk2(v[6], v[7]); *(u32x4*)p = w; }
__device__ __forceinline__ float wave_sum(float v) {
#pragma unroll
    for (int o = 1; o < 64; o <<= 1) v += __shfl_xor(v, o);
    return v;
}
__device__ __forceinline__ float silu_f(float v) { return v / (1.f + __expf(-v)); }
__device__ __forceinline__ void unpack8(const u32x4 w, float* f) {
    f[0] = bf2f(w.x & 0xffffu); f[1] = bf2f(w.x >> 16); f[2] = bf2f(w.y & 0xffffu); f[3] = bf2f(w.y >> 16);
    f[4] = bf2f(w.z & 0xffffu); f[5] = bf2f(w.z >> 16); f[6] = bf2f(w.w & 0xffffu); f[7] = bf2f(w.w >> 16);
}

struct Args { const float* in[22]; float* out; unsigned char* ws; int ph_lo, ph_hi; };
enum { I_X = 0, I_C, I_CTX, I_CCTX, I_ADAW, I_ADAB, I_NORMG, I_FINALG, I_ABWIN, I_ABWOUT, I_RETDEC, I_RETGN, I_RPB, I_SWAWIN, I_SWAWOUT, I_SINK,
       I_RGW, I_RGB, I_REW, I_REB, I_WGU, I_WDN };

struct Ctx {
    const float* in[22]; float* out; unsigned char* ws;
    LAS unsigned char* lds;
    int tid, lane, wave, blk, nblk;
};

template <class DMap>
__device__ __forceinline__ void transpose_item(const float* W, int K, int N, bf16_t* WT, int k0, int n0, const DMap& dmap, LAS float* scr, int lane) {
    const int c4 = lane & 15, kr = lane >> 4;
#pragma unroll
    for (int i = 0; i < 16; ++i) { const int kk = 4 * i + kr; *(LAS f32x4*)(scr + kk * 68 + 4 * c4) = __builtin_nontemporal_load((const f32x4*)(W + (size_t)(k0 + kk) * N + n0 + 4 * c4)); }
    asm volatile("s_waitcnt lgkmcnt(0)" ::: "memory");
    const int c = lane & 7;
#pragma unroll
    for (int j = 0; j < 8; ++j) { const int n = (lane >> 3) + 8 * j; const LAS float* sp = scr + (8 * c) * 68 + n;
        u32x4 o; o.x = pk2(sp[0 * 68], sp[1 * 68]); o.y = pk2(sp[2 * 68], sp[3 * 68]); o.z = pk2(sp[4 * 68], sp[5 * 68]); o.w = pk2(sp[6 * 68], sp[7 * 68]);
        __builtin_nontemporal_store(o, (u32x4*)(WT + (size_t)dmap(n0 + n) * K + k0 + 8 * c)); }
    asm volatile("s_waitcnt lgkmcnt(0)" ::: "memory");
}
struct DMapId { __device__ __forceinline__ int operator()(int n) const { return n; } };
__device__ __forceinline__ int gu_row(int n) { const int u = n >= 512, g = n & 511; return 256 * (g >> 7) + 128 * u + (g & 127); }
struct DMapGU { __device__ __forceinline__ int operator()(int n) const { return gu_row(n); } };

__device__ __forceinline__ void phase_prep(Ctx& F) {
    if (F.blk < 192) {
        const int l = F.blk / 96, col0 = (F.blk % 96) * 64;
        LAS float* s = (LAS float*)F.lds;
        LAS float* red = (LAS float*)(F.lds + 17 * 1024 * 4);
        for (int idx = F.tid; idx < 17 * 1024; idx += NTHREADS) { const int r = idx >> 10, k = idx & 1023; const float v = r < 16 ? F.in[I_C][r * 1024 + k] : F.in[I_CCTX][k]; s[idx] = silu_f(v); }
        __syncthreads();
        float acc[17];
#pragma unroll
        for (int r = 0; r < 17; ++r) acc[r] = 0.f;
        const float* wp = F.in[I_ADAW] + ((size_t)l * 1024 + F.wave * 128) * 6144 + col0 + F.lane;
        for (int k0 = 0; k0 < 128; k0 += 16) { float wv[16];
#pragma unroll
            for (int j = 0; j < 16; ++j) wv[j] = __builtin_nontemporal_load(wp + (size_t)(k0 + j) * 6144);
#pragma unroll
            for (int j = 0; j < 16; ++j)
#pragma unroll
                for (int r = 0; r < 17; ++r) acc[r] += s[r * 1024 + F.wave * 128 + k0 + j] * wv[j]; }
#pragma unroll
        for (int r = 0; r < 17; ++r) red[(F.wave * 17 + r) * 64 + F.lane] = acc[r];
        __syncthreads();
        float* mod = (float*)(F.ws + WS_MOD);
        for (int idx = F.tid; idx < 17 * 64; idx += NTHREADS) { const int r = idx >> 6, cl = idx & 63; float v = F.in[I_ADAB][l * 6144 + col0 + cl];
#pragma unroll
            for (int w = 0; w < 8; ++w) v += red[(w * 17 + r) * 64 + cl];
            mod[(size_t)(l * 17 + r) * 6144 + col0 + cl] = v; }
        asm volatile("s_waitcnt vmcnt(0)" ::: "memory");
        __syncthreads();
        if (F.tid == 0) { __builtin_amdgcn_fence(__ATOMIC_RELEASE, "agent"); asm volatile("s_waitcnt vmcnt(0)" ::: "memory");
            __hip_atomic_fetch_add((unsigned*)(F.ws + WS_CTL) + 400, 1u, __ATOMIC_RELAXED, __HIP_MEMORY_SCOPE_AGENT); }
    }
    if (F.blk == F.nblk - 1) {
        float* rt = (float*)(F.ws + WS_ROPE);
        for (int idx = F.tid; idx < 1024; idx += NTHREADS) { const int pos = idx >> 4, f = idx & 15;
            const float inv = exp2f(-(float)f * (13.287712379549449f / 16.f));
            const float ang = (float)pos * inv; const double rev = (double)ang * 0.15915494309189535; const float fr = (float)(rev - floor(rev));
            rt[idx * 2] = __builtin_amdgcn_cosf(fr); rt[idx * 2 + 1] = __builtin_amdgcn_sinf(fr); }
    }
    if (F.blk == F.nblk - 2) {
        bf16_t* rw = (bf16_t*)(F.ws + WS_RW);
        for (int idx = F.tid; idx < 2 * 48 * 1024; idx += NTHREADS) { const int l = idx / 49152, rem = idx % 49152, c = rem >> 10, k = rem & 1023;
            const float w = c < 4 ? F.in[I_RGW][(size_t)(l * 1024 + k) * 4 + c] : (c < 36 ? F.in[I_REW][(size_t)(l * 1024 + k) * 32 + c - 4] : 0.f);
            const unsigned h = f2bf(w); const float r = w - bf2f(h);
            rw[(size_t)(l * 2) * 49152 + rem] = (bf16_t)h; rw[(size_t)(l * 2 + 1) * 49152 + rem] = (bf16_t)f2bf(r); }
    }
    __syncthreads();
    LAS float* scr = (LAS float*)(F.lds + F.wave * 17408);
    const int gw = F.blk * NWAVES + F.wave, NGW = F.nblk * NWAVES;
    constexpr int I0 = 16 * 56, I1 = 16 * 16, I2 = 16 * 24, I3 = 16 * 16, I4 = 32 * 16 * 16, I5 = 32 * 8 * 16;
    unsigned* q = (unsigned*)(F.ws + WS_CTL) + 208; LAS unsigned* qb = (LAS unsigned*)(F.lds + 139264 + 64);
    for (;;) {
        __syncthreads();
        if (F.tid == 0) *qb = atomicAdd(q, 8u);
        __syncthreads();
        const unsigned base = *qb; if (base >= (unsigned)(I0 + I1 + I2 + I3 + I4 + I5)) break;
        int r = (int)base + F.wave; if (r >= I0 + I1 + I2 + I3 + I4 + I5) continue;
        if (r < I0) { transpose_item(F.in[I_ABWIN], 1024, ABIN, (bf16_t*)(F.ws + WS_WIN0), 64 * (r / 56), 64 * (r % 56), DMapId{}, scr, F.lane); continue; } r -= I0;
        if (r < I1) { transpose_item(F.in[I_ABWOUT], 1024, 1024, (bf16_t*)(F.ws + WS_WOUT0), 64 * (r / 16), 64 * (r % 16), DMapId{}, scr, F.lane); continue; } r -= I1;
        if (r < I2) { transpose_item(F.in[I_SWAWIN], 1024, SWAIN, (bf16_t*)(F.ws + WS_WIN1), 64 * (r / 24), 64 * (r % 24), DMapId{}, scr, F.lane); continue; } r -= I2;
        if (r < I3) { transpose_item(F.in[I_SWAWOUT], 1024, 1024, (bf16_t*)(F.ws + WS_WOUT1), 64 * (r / 16), 64 * (r % 16), DMapId{}, scr, F.lane); continue; } r -= I3;
        if (r < I4) { const int e = r / 256, q2 = r % 256;
            transpose_item(F.in[I_WGU] + (size_t)e * 1024 * 1024, 1024, 1024, (bf16_t*)(F.ws + WS_WGU) + (size_t)e * 1024 * 1024, 64 * (q2 / 16), 64 * (q2 % 16), DMapGU{}, scr, F.lane); continue; } r -= I4;
        { const int e = r / 128, q2 = r % 128;
            transpose_item(F.in[I_WDN] + (size_t)e * 512 * 1024, 512, 1024, (bf16_t*)(F.ws + WS_WDN) + (size_t)e * 1024 * 512, 64 * (q2 / 16), 64 * (q2 % 16), DMapId{}, scr, F.lane); }
    }
}
__device__ __forceinline__ void conv_tail(Ctx& F, int first, int item0, int jlo, int jhi) {
    __syncthreads();
    if (F.blk < first) return;
    LAS float* scr = (LAS float*)(F.lds + F.wave * 17408);
    const int wi = (F.blk - first) * NWAVES + F.wave;
    for (int j = jlo; j < jhi; ++j) { const int it = item0 + wi * 4 + j; if (it >= 12288) break;
        if (it < 8192) { const int e = 32 + it / 256, q = it % 256;
            transpose_item(F.in[I_WGU] + (size_t)e * 1024 * 1024, 1024, 1024, (bf16_t*)(F.ws + WS_WGU) + (size_t)e * 1024 * 1024, 64 * (q / 16), 64 * (q % 16), DMapGU{}, scr, F.lane); }
        else { const int r = it - 8192, e = 32 + r / 128, q = r % 128;
            transpose_item(F.in[I_WDN] + (size_t)e * 512 * 1024, 512, 1024, (bf16_t*)(F.ws + WS_WDN) + (size_t)e * 1024 * 512, 64 * (q / 16), 64 * (q % 16), DMapId{}, scr, F.lane); } }
}

struct RowMod { float a[16], s[16]; };
__device__ __forceinline__ void load_rowmod(const Ctx& F, int l, int which, int b, RowMod& M) {
    const float* mod = (const float*)(F.ws + WS_MOD) + (size_t)(l * 17 + b) * 6144;
    const float* g = F.in[I_NORMG] + (size_t)(l * 2 + which) * 1024;
#pragma unroll
    for (int j = 0; j < 4; ++j) { const int c = 4 * F.lane + 256 * j;
        const f32x4 gv = *(const f32x4*)(g + c), sh = *(const f32x4*)(mod + which * 3072 + c), sc = *(const f32x4*)(mod + which * 3072 + 1024 + c);
#pragma unroll
        for (int i = 0; i < 4; ++i) { M.a[4 * j + i] = gv[i] * (1.f + sc[i]); M.s[4 * j + i] = sh[i]; } }
}
__device__ __forceinline__ void load_row16(const float* p, int lane, float* v) {
#pragma unroll
    for (int j = 0; j < 4; ++j) { const f32x4 t = __builtin_nontemporal_load((const f32x4*)(p + 4 * lane + 256 * j)); v[4 * j] = t[0]; v[4 * j + 1] = t[1]; v[4 * j + 2] = t[2]; v[4 * j + 3] = t[3]; }
}
__device__ __forceinline__ void load_row16_bf16(const bf16_t* p, int lane, float* v) {
#pragma unroll
    for (int j = 0; j < 4; ++j) { const u32x2 w = *(const u32x2*)(p + 4 * lane + 256 * j); v[4 * j] = bf2f(w.x & 0xffffu); v[4 * j + 1] = bf2f(w.x >> 16); v[4 * j + 2] = bf2f(w.y & 0xffffu); v[4 * j + 3] = bf2f(w.y >> 16); }
}
__device__ __forceinline__ void load_row16_bf16_nt(const bf16_t* p, int lane, float* v) {
#pragma unroll
    for (int j = 0; j < 4; ++j) { const u32x2 w = __builtin_nontemporal_load((const u32x2*)(p + 4 * lane + 256 * j)); v[4 * j] = bf2f(w.x & 0xffffu); v[4 * j + 1] = bf2f(w.x >> 16); v[4 * j + 2] = bf2f(w.y & 0xffffu); v[4 * j + 3] = bf2f(w.y >> 16); }
}
__device__ __forceinline__ void store_row16_bf16(bf16_t* p, int lane, const float* v) {
#pragma unroll
    for (int j = 0; j < 4; ++j) { u32x2 w; w.x = pk2(v[4 * j], v[4 * j + 1]); w.y = pk2(v[4 * j + 2], v[4 * j + 3]); *(u32x2*)(p + 4 * lane + 256 * j) = w; }
}
__device__ __forceinline__ void store_row16_f32(float* p, int lane, const float* v) {
#pragma unroll
    for (int j = 0; j < 4; ++j) { f32x4 t = {v[4 * j], v[4 * j + 1], v[4 * j + 2], v[4 * j + 3]}; *(f32x4*)(p + 4 * lane + 256 * j) = t; }
}
__device__ __forceinline__ void store_row16_f32_nt(float* p, int lane, const float* v) {
#pragma unroll
    for (int j = 0; j < 4; ++j) { f32x4 t = {v[4 * j], v[4 * j + 1], v[4 * j + 2], v[4 * j + 3]}; __builtin_nontemporal_store(t, (f32x4*)(p + 4 * lane + 256 * j)); }
}
__device__ __forceinline__ float row_rstd(const float* v) {
    float ss = 0.f;
#pragma unroll
    for (int i = 0; i < 16; ++i) ss += v[i] * v[i];
    return rsqrtf(wave_sum(ss) * (1.f / 1024.f) + 1e-6f);
}

__device__ __forceinline__ const float* xrow_in(const Ctx& F, int row) { return row < NL ? F.in[I_X] + (size_t)row * D : F.in[I_CTX] + (size_t)(row - NL) * D; }
__device__ __forceinline__ bf16_t* xrow_cur(const Ctx& F, int row) { return (bf16_t*)(F.ws + WS_XB) + (size_t)row * D; }
__device__ __forceinline__ void wait_mod(Ctx& F) {
    if (F.tid == 0) { unsigned* flag = (unsigned*)(F.ws + WS_CTL) + 400; unsigned spins = 0;
        while (__hip_atomic_load(flag, __ATOMIC_RELAXED, __HIP_MEMORY_SCOPE_AGENT) < 192u) { __builtin_amdgcn_s_sleep(4); if (++spins > (1u << 22)) break; }
        __builtin_amdgcn_fence(__ATOMIC_ACQUIRE, "agent"); asm volatile("s_waitcnt vmcnt(0)" ::: "memory"); }
    __syncthreads();
}
__device__ __forceinline__ void phase_norm0(Ctx& F) {
    bf16_t* H = (bf16_t*)(F.ws + WS_H);
    const int r0 = (F.blk * NWAVES + F.wave) * 18, r1 = r0 + 18 < NTOK ? r0 + 18 : NTOK; int curb = -1; RowMod M;
    float nx[16]; if (r0 < r1) load_row16(xrow_in(F, r0), F.lane, nx);
    for (int row = r0; row < r1; ++row) {
        float v[16];
#pragma unroll
        for (int i = 0; i < 16; ++i) v[i] = nx[i];
        load_row16(xrow_in(F, row + 1 < r1 ? row + 1 : row), F.lane, nx);
        const int b = row < NL ? row >> 11 : 16;
        if (b != curb) { load_rowmod(F, 0, 0, b, M); curb = b; }
        const float rstd = row_rstd(v);
#pragma unroll
        for (int i = 0; i < 16; ++i) v[i] = v[i] * rstd * M.a[i] + M.s[i];
        store_row16_bf16(H + (size_t)row * D, F.lane, v);
    }
}

__device__ __forceinline__ void phase_cvec(Ctx& F) {
    if (F.blk >= 34) return;
    const int l = F.blk / 17, b = F.blk % 17;
    const float* sh = (const float*)(F.ws + WS_MOD) + (size_t)(l * 17 + b) * 6144 + 3072;
    LAS float* red = (LAS float*)F.lds;
    const int kg = F.tid >> 5, c = F.tid & 31;
    float acc = 0.f, accg = 0.f;
    for (int k = kg * 64; k < kg * 64 + 64; ++k) { const float sv = sh[k]; acc += sv * F.in[I_REW][(size_t)(l * 1024 + k) * 32 + c]; if (c < 4) accg += sv * F.in[I_RGW][(size_t)(l * 1024 + k) * 4 + c]; }
    red[kg * 36 + 4 + c] = acc; if (c < 4) red[kg * 36 + c] = accg;
    __syncthreads();
    if (F.tid < 36) { float v = F.tid < 4 ? F.in[I_RGB][l * 4 + F.tid] : F.in[I_REB][l * 32 + F.tid - 4];
#pragma unroll
        for (int g = 0; g < 16; ++g) v += red[g * 36 + F.tid];
        ((float*)(F.ws + WS_ROUTE + RT_CVEC))[(l * 17 + b) * 48 + F.tid] = v; }
    __syncthreads();
}
typedef float f32x4v __attribute__((ext_vector_type(4)));
__device__ __forceinline__ void phase_router(Ctx& F, int l, int nrows) {
    LAS float* av = (LAS float*)F.lds;
    LAS float* sv = av + 2048;
    LAS float* cv = sv + 2048;
    LAS int* cnt = (LAS int*)(cv + 96);
    LAS float* part = (LAS float*)(cnt + 32);
    const int row_lo = F.blk * 144; const int row_hi = row_lo + 144 < nrows ? row_lo + 144 : nrows;
    if (F.tid < 32) cnt[F.tid] = 0;
    if (row_lo < nrows) {
        const int b0 = row_lo < NL ? row_lo >> 11 : 16, b1 = (row_hi - 1) < NL ? (row_hi - 1) >> 11 : 16;
        const float* g = F.in[I_NORMG] + (size_t)(l * 2 + 1) * 1024;
        for (int idx = F.tid; idx < 2048; idx += NTHREADS) { const int w = idx >> 10, k = idx & 1023; const float* mod = (const float*)(F.ws + WS_MOD) + (size_t)(l * 17 + (w ? b1 : b0)) * 6144;
            av[idx] = g[k] * (1.f + mod[4096 + k]); sv[idx] = mod[3072 + k]; }
        if (F.tid < 96) { const int w = F.tid / 48, c = F.tid % 48; cv[F.tid] = c < 36 ? ((const float*)(F.ws + WS_ROUTE + RT_CVEC))[(l * 17 + (w ? b1 : b0)) * 48 + c] : 0.f; }
        int* tok_e = (int*)(F.ws + WS_ROUTE + RT_TOKE); float* tok_w = (float*)(F.ws + WS_ROUTE + RT_TOKW); int* tok_r = (int*)(F.ws + WS_ROUTE + RT_TOKR); float* rstd_o = (float*)(F.ws + WS_ROUTE + RT_RSTD);
        const bf16_t* whi = (const bf16_t*)(F.ws + WS_RW) + (size_t)(l * 2) * 49152; const bf16_t* wlo = whi + 49152;
        const int n = F.lane & 15, kq = F.lane >> 4, kw = 128 * F.wave + 8 * kq;
        bf16x8 Wh[4][3], Wl[4][3];
#pragma unroll
        for (int i = 0; i < 4; ++i)
#pragma unroll
            for (int cb = 0; cb < 3; ++cb) { Wh[i][cb] = *(const bf16x8*)(whi + (size_t)(cb * 16 + n) * 1024 + kw + 32 * i); Wl[i][cb] = *(const bf16x8*)(wlo + (size_t)(cb * 16 + n) * 1024 + kw + 32 * i); }
        const int ntask = (row_hi - row_lo) >> 4;
        u32x4 xq[4], xn[4];
#pragma unroll
        for (int i = 0; i < 4; ++i) xq[i] = *(const u32x4*)(xrow_cur(F, row_lo + n) + kw + 32 * i);
        __syncthreads();
        for (int task = 0; task < ntask; ++task) {
            const int r0 = row_lo + 16 * task; const int b = r0 < NL ? r0 >> 11 : 16; const int w = (b == b0) ? 0 : 1;
            { const int rn = task + 1 < ntask ? r0 + 16 : r0;
#pragma unroll
              for (int i = 0; i < 4; ++i) xn[i] = *(const u32x4*)(xrow_cur(F, rn + n) + kw + 32 * i); }
            f32x4v acc[3]; acc[0] = f32x4v{0.f, 0.f, 0.f, 0.f}; acc[1] = acc[0]; acc[2] = acc[0]; float ss = 0.f;
#pragma unroll
            for (int i = 0; i < 4; ++i) { const int k0 = kw + 32 * i;
                float xx[8]; unpack8(xq[i], xx);
                const f32x4 a0 = *(const LAS f32x4*)(av + w * 1024 + k0), a1 = *(const LAS f32x4*)(av + w * 1024 + k0 + 4);
                float xa[8]; unsigned hb[8]; float lo[8];
#pragma unroll
                for (int j = 0; j < 4; ++j) { xa[j] = xx[j] * a0[j]; xa[4 + j] = xx[4 + j] * a1[j]; ss += xx[j] * xx[j] + xx[4 + j] * xx[4 + j]; }
#pragma unroll
                for (int j = 0; j < 8; ++j) { hb[j] = f2bf(xa[j]); lo[j] = xa[j] - bf2f(hb[j]); }
                u32x4 bh, bl; bh.x = hb[0] | (hb[1] << 16); bh.y = hb[2] | (hb[3] << 16); bh.z = hb[4] | (hb[5] << 16); bh.w = hb[6] | (hb[7] << 16);
                bl.x = pk2(lo[0], lo[1]); bl.y = pk2(lo[2], lo[3]); bl.z = pk2(lo[4], lo[5]); bl.w = pk2(lo[6], lo[7]);
                const bf16x8 Bh = __builtin_bit_cast(bf16x8, bh), Bl = __builtin_bit_cast(bf16x8, bl);
#pragma unroll
                for (int cb = 0; cb < 3; ++cb) {
                    acc[cb] = __builtin_amdgcn_mfma_f32_16x16x32_bf16(Wh[i][cb], Bh, acc[cb], 0, 0, 0);
                    acc[cb] = __builtin_amdgcn_mfma_f32_16x16x32_bf16(Wh[i][cb], Bl, acc[cb], 0, 0, 0);
                    acc[cb] = __builtin_amdgcn_mfma_f32_16x16x32_bf16(Wl[i][cb], Bh, acc[cb], 0, 0, 0); }
                __builtin_amdgcn_sched_barrier(0); }
            ss += __shfl_xor(ss, 16); ss += __shfl_xor(ss, 32);
            LAS float* pb = part + ((task & 1) * 8 + F.wave) * 16 * 52 + n * 52;
#pragma unroll
            for (int cb = 0; cb < 3; ++cb) *(LAS f32x4v*)(pb + cb * 16 + 4 * kq) = acc[cb];
            if (kq == 0) pb[48] = ss;
            __syncthreads();
            { const LAS float* pq = part + (task & 1) * 8 * 16 * 52 + n * 52 + 48; float sq = 0.f;
#pragma unroll
              for (int ww = 0; ww < 8; ++ww) sq += pq[ww * 16 * 52];
              const float rstd = rsqrtf(sq * (1.f / 1024.f) + 1e-6f); bf16_t* hp = (bf16_t*)(F.ws + WS_H) + (size_t)(r0 + n) * D;
#pragma unroll
              for (int i = 0; i < 4; ++i) { const int k0 = kw + 32 * i; float xx[8], hh[8]; unpack8(xq[i], xx);
                  const f32x4 a0 = *(const LAS f32x4*)(av + w * 1024 + k0), a1 = *(const LAS f32x4*)(av + w * 1024 + k0 + 4), s0 = *(const LAS f32x4*)(sv + w * 1024 + k0), s1 = *(const LAS f32x4*)(sv + w * 1024 + k0 + 4);
#pragma unroll
                  for (int j = 0; j < 4; ++j) { hh[j] = xx[j] * rstd * a0[j] + s0[j]; hh[4 + j] = xx[4 + j] * rstd * a1[j] + s1[j]; }
                  store8_bf16(hp + k0, hh); } }
            if (F.wave == (task & 7) && F.lane < 16) {
                const int row = r0 + n; const LAS float* p0 = part + (task & 1) * 8 * 16 * 52 + n * 52;
                float lg[36]; float sq = 0.f;
#pragma unroll
                for (int c = 0; c < 36; ++c) lg[c] = 0.f;
#pragma unroll 1
                for (int ww = 0; ww < 8; ++ww) { const LAS float* pp = p0 + ww * 16 * 52;
#pragma unroll
                    for (int c4 = 0; c4 < 9; ++c4) { const f32x4v t = *(const LAS f32x4v*)(pp + 4 * c4); lg[4 * c4] += t[0]; lg[4 * c4 + 1] += t[1]; lg[4 * c4 + 2] += t[2]; lg[4 * c4 + 3] += t[3]; }
                    sq += pp[48]; }
                const float rstd = rsqrtf(sq * (1.f / 1024.f) + 1e-6f);
#pragma unroll
                for (int c = 0; c < 36; ++c) lg[c] = rstd * lg[c] + cv[w * 48 + c];
                int gi = 0; float gm = lg[0]; if (lg[1] > gm) { gm = lg[1]; gi = 1; } if (lg[2] > gm) { gm = lg[2]; gi = 2; } if (lg[3] > gm) { gm = lg[3]; gi = 3; }
                const float gwt = 1.f / (__expf(lg[0] - gm) + __expf(lg[1] - gm) + __expf(lg[2] - gm) + __expf(lg[3] - gm));
                float le[8];
#pragma unroll
                for (int i = 0; i < 8; ++i) { le[i] = lg[4 + i]; if (gi == 1) le[i] = lg[12 + i]; if (gi == 2) le[i] = lg[20 + i]; if (gi == 3) le[i] = lg[28 + i]; }
                int i0 = 0; float v0 = le[0];
#pragma unroll
                for (int i = 1; i < 8; ++i) if (le[i] > v0) { v0 = le[i]; i0 = i; }
                int i1 = -1; float v1 = -3.0e38f;
#pragma unroll
                for (int i = 0; i < 8; ++i) if (i != i0 && le[i] > v1) { v1 = le[i]; i1 = i; }
                const float ex = __expf(v1 - v0), t0 = 1.f / (1.f + ex), t1 = ex * t0;
                const int e0 = gi * 8 + i0, e1 = gi * 8 + i1;
                tok_e[row * 2] = e0; tok_e[row * 2 + 1] = e1; tok_w[row * 2] = gwt * t0; tok_w[row * 2 + 1] = gwt * t1;
                tok_r[row * 2] = atomicAdd((int*)&cnt[e0], 1); tok_r[row * 2 + 1] = atomicAdd((int*)&cnt[e1], 1);
                rstd_o[row] = rstd;
            }
#pragma unroll
            for (int i = 0; i < 4; ++i) xq[i] = xn[i];
        }
    }
    __syncthreads();
    if (F.tid < 32) ((int*)(F.ws + WS_ROUTE + RT_BCNT))[F.blk * 32 + F.tid] = cnt[F.tid];
}

__device__ __forceinline__ void phase_slots(Ctx& F, int l, int nrows) {
    LAS int* base = (LAS int*)F.lds;
    const int* bc = (const int*)(F.ws + WS_ROUTE + RT_BCNT);
    { const int g = F.tid >> 5, e = F.tid & 31; int tot = 0, below = 0;
      for (int b = g; b < F.nblk; b += 16) { const int c = bc[b * 32 + e]; tot += c; if (b < F.blk) below += c; }
      base[128 + g * 32 + e] = tot; base[640 + g * 32 + e] = below; }
    __syncthreads();
    if (F.tid < 32) { int tot = 0, below = 0;
#pragma unroll
        for (int g = 0; g < 16; ++g) { tot += base[128 + g * 32 + F.tid]; below += base[640 + g * 32 + F.tid]; }
        base[64 + F.tid] = (tot + 255) & ~255; base[F.tid] = below; }
    __syncthreads();
    if (F.tid == 0) { int off = 0; for (int e = 0; e < 32; ++e) { const int p = base[64 + e]; base[32 + e] = off; base[e] += off; off += p; }
        base[96] = off; }
    __syncthreads();
    if (F.blk == 0) { int* te = (int*)(F.ws + WS_ROUTE + RT_TILEE); const int nt = base[96] >> 8;
        for (int t = F.tid; t < nt; t += NTHREADS) { int e = 0; for (int q = 1; q < 32; ++q) if (base[32 + q] <= t * 256) e = q; te[t] = e; }
        if (F.tid == 0) te[320] = nt; }
    const int* tok_e = (const int*)(F.ws + WS_ROUTE + RT_TOKE); const int* tok_r = (const int*)(F.ws + WS_ROUTE + RT_TOKR); int* tok_s = (int*)(F.ws + WS_ROUTE + RT_TOKS);
    int* stok = (int*)(F.ws + WS_STOK);
    for (int i = F.tid; i < 288; i += NTHREADS) { const int row = F.blk * 144 + (i >> 1); if (row < nrows) { const int sl = base[tok_e[row * 2 + (i & 1)]] + tok_r[row * 2 + (i & 1)]; tok_s[row * 2 + (i & 1)] = sl; stok[sl] = row; } }
}

__device__ __forceinline__ void load_yrow(const bf16_t* Y, int sl, int lane, u32x2* y) {
#pragma unroll
    for (int j = 0; j < 4; ++j) y[j] = __builtin_nontemporal_load((const u32x2*)(Y + (size_t)sl * D + 4 * lane + 256 * j));
}
__device__ __forceinline__ void phase_combine(Ctx& F, int l) {
    const int nrows = l == 0 ? NTOK : NL;
    const int* tok_s = (const int*)(F.ws + WS_ROUTE + RT_TOKS); const float* tok_w = (const float*)(F.ws + WS_ROUTE + RT_TOKW);
    const bf16_t* Y = (const bf16_t*)(F.ws + WS_Y); bf16_t* H = (bf16_t*)(F.ws + WS_H);
    const float* mod = (const float*)(F.ws + WS_MOD);
    const int r0 = (F.blk * NWAVES + F.wave) * 18, r1 = r0 + 18 < nrows ? r0 + 18 : nrows; int curb = -1; RowMod M; float g2[16];
    float fg[16];
    if (l == 1) load_row16(F.in[I_FINALG], F.lane, fg);
    if (r0 >= r1) return;
    float nx[16]; u32x2 ny0[4], ny1[4]; float nw0, nw1; int ps0, ps1; float pw0, pw1;
    { const int sa = tok_s[r0 * 2], sb = tok_s[r0 * 2 + 1]; nw0 = tok_w[r0 * 2]; nw1 = tok_w[r0 * 2 + 1];
      load_row16_bf16_nt(xrow_cur(F, r0), F.lane, nx); load_yrow(Y, sa, F.lane, ny0); load_yrow(Y, sb, F.lane, ny1);
      const int rn = r0 + 1 < r1 ? r0 + 1 : r0; ps0 = tok_s[rn * 2]; ps1 = tok_s[rn * 2 + 1]; pw0 = tok_w[rn * 2]; pw1 = tok_w[rn * 2 + 1]; }
    for (int row = r0; row < r1; ++row) {
        float v[16]; u32x2 y0[4], y1[4]; const float w0 = nw0, w1 = nw1;
#pragma unroll
        for (int i = 0; i < 16; ++i) v[i] = nx[i];
#pragma unroll
        for (int j = 0; j < 4; ++j) { y0[j] = ny0[j]; y1[j] = ny1[j]; }
        { const int rn = row + 1 < r1 ? row + 1 : row, rn2 = row + 2 < r1 ? row + 2 : rn;
          load_row16_bf16_nt(xrow_cur(F, rn), F.lane, nx); load_yrow(Y, ps0, F.lane, ny0); load_yrow(Y, ps1, F.lane, ny1); nw0 = pw0; nw1 = pw1;
          ps0 = tok_s[rn2 * 2]; ps1 = tok_s[rn2 * 2 + 1]; pw0 = tok_w[rn2 * 2]; pw1 = tok_w[rn2 * 2 + 1]; }
        const int b = row < NL ? row >> 11 : 16;
        if (b != curb) { if (l == 0) load_rowmod(F, 1, 0, b, M); load_row16(mod + (size_t)(l * 17 + b) * 6144 + 5 * 1024, F.lane, g2); curb = b; }

#pragma unroll
        for (int j = 0; j < 4; ++j) { const u32x2 a = y0[j], c = y1[j];
            const float q0 = w0 * bf2f(a.x & 0xffffu) + w1 * bf2f(c.x & 0xffffu), q1 = w0 * bf2f(a.x >> 16) + w1 * bf2f(c.x >> 16);
            const float q2 = w0 * bf2f(a.y & 0xffffu) + w1 * bf2f(c.y & 0xffffu), q3 = w0 * bf2f(a.y >> 16) + w1 * bf2f(c.y >> 16);
            v[4 * j] += g2[4 * j] * q0; v[4 * j + 1] += g2[4 * j + 1] * q1; v[4 * j + 2] += g2[4 * j + 2] * q2; v[4 * j + 3] += g2[4 * j + 3] * q3; }
        const float rstd = row_rstd(v);
        if (l == 0) {
            store_row16_bf16(xrow_cur(F, row), F.lane, v);
#pragma unroll
            for (int i = 0; i < 16; ++i) v[i] = v[i] * rstd * M.a[i] + M.s[i];
            store_row16_bf16(H + (size_t)row * D, F.lane, v);
        } else {
#pragma unroll
            for (int i = 0; i < 16; ++i) v[i] = v[i] * rstd * fg[i];
            store_row16_f32_nt(F.out + (size_t)row * D, F.lane, v);
        }
    }
}

struct GemmDesc { const bf16_t* A; int lda; const bf16_t* Bt; int K; int nM, nN; const int* tile_e; size_t estride; const int* gather = nullptr; };

template <class Epi>
__device__ __forceinline__ void gemm_naive(Ctx& F, const GemmDesc g, const Epi& E) {
    const int wr = F.wave >> 2, wc = F.wave & 3, fr = F.lane & 15, fq = F.lane >> 4;
    const int nun = g.nM * g.nN;
    for (int u = F.blk; u < nun; u += F.nblk) {
        const int pm = u / g.nN, pn = u % g.nN;
        const bf16_t* Bt = g.Bt + (g.tile_e ? (size_t)g.tile_e[pm] * g.estride : 0);
        const bf16_t* bp = Bt + (size_t)(256 * pn + 32 * wc + 8 * fq) * g.K;
        for (int am = 0; am < 8; ++am) {
            const int ai = am >> 2, m = am & 3, row = 256 * pm + 128 * ai + 64 * wr + 16 * m + fr;
            const bf16_t* ap = g.A + (size_t)row * g.lda;
            float v0[8], v1[8];
#pragma unroll
            for (int i = 0; i < 8; ++i) { v0[i] = 0.f; v1[i] = 0.f; }
            for (int k0 = 0; k0 < g.K; k0 += 8) {
                float a[8]; unpack8(*(const u32x4*)(ap + k0), a);
#pragma unroll
                for (int i = 0; i < 8; ++i) { float b[8]; unpack8(*(const u32x4*)(bp + (size_t)i * g.K + k0), b);
#pragma unroll
                    for (int q = 0; q < 8; ++q) v0[i] += a[q] * b[q];
                    unpack8(*(const u32x4*)(bp + (size_t)(128 + i) * g.K + k0), b);
#pragma unroll
                    for (int q = 0; q < 8; ++q) v1[i] += a[q] * b[q]; }
            }
            E(row, pn, 32 * wc + 8 * fq, v0, v1);
        }
    }
}


__device__ __forceinline__ void rope8(float* v, int row, int colbase, const float* rt) {
    const int lane = (int)__builtin_amdgcn_mbcnt_hi(~0u, __builtin_amdgcn_mbcnt_lo(~0u, 0u)), fq = lane >> 4;
    const int t = row & (SEQ - 1), axis = (colbase >> 5) & 1, pos = axis ? (t & 63) : (t >> 6);
    const bool x2 = fq >= 2; const int f0 = 8 * (fq & 1);
    const f32x4* tp = (const f32x4*)(rt + (pos * 16 + f0) * 2);
    const f32x4 t0 = tp[0], t1 = tp[1], t2 = tp[2], t3 = tp[3];
    const float cs[16] = {t0[0], t0[1], t0[2], t0[3], t1[0], t1[1], t1[2], t1[3], t2[0], t2[1], t2[2], t2[3], t3[0], t3[1], t3[2], t3[3]};
#pragma unroll
    for (int i = 0; i < 8; ++i) { const unsigned u = __float_as_uint(v[i]); auto rr = __builtin_amdgcn_permlane32_swap(u, u, false, false);
        const float p = __uint_as_float(x2 ? rr[0] : rr[1]); const float c = cs[2 * i], sn = cs[2 * i + 1];
        v[i] = x2 ? v[i] * c + p * sn : v[i] * c - p * sn; }
}
struct EpiIn0 { bf16_t* O; const float* rt;
    __device__ __forceinline__ void operator()(int row, int pn, int cl, float* v0, float* v1) const {
        const bool lat = row < NL;
        if (pn < 4) { if (lat) { rope8(v0, row, cl, rt); rope8(v1, row, cl + 128, rt); }
            if (pn >= 2) {
#pragma unroll
                for (int i = 0; i < 8; ++i) { v0[i] *= 0.125f; v1[i] *= 0.125f; } } }
        else if (pn == 8 || pn == 9) {
#pragma unroll
            for (int i = 0; i < 8; ++i) { v0[i] *= 0.125f * LOG2E; v1[i] *= 0.125f * LOG2E; } }
        bf16_t* p = O + (size_t)row * ABIN + 256 * pn + cl; store8_bf16(p, v0); store8_bf16(p + 128, v1);
    } };
struct EpiIn1 { bf16_t* O; const float* rt; int col0; int rowoff;
    __device__ __forceinline__ void operator()(int row, int pn, int cl, float* v0, float* v1) const {
        const int c = col0 + 256 * pn; row += rowoff;
        if (row < NL && c < 1280) { rope8(v0, row, cl, rt); rope8(v1, row, cl + 128, rt); }
        if (c < 1024) {
#pragma unroll
            for (int i = 0; i < 8; ++i) { v0[i] *= 0.125f * LOG2E; v1[i] *= 0.125f * LOG2E; } }
        bf16_t* p = O + (size_t)row * SWAIN + c + cl; store8_bf16(p, v0); store8_bf16(p + 128, v1);
    } };
struct EpiResPre { float xo[16]; };
struct EpiRes { static constexpr bool PREFETCH = true; const float* xl; const float* xc; bf16_t* xb; const float* mod;
    __device__ __forceinline__ void load(int row, int pn, int cl, EpiResPre& P) const {
        const float* src = row < NL ? xl + (size_t)row * D : xc + (size_t)(row - NL) * D; const bf16_t* dst = xb + (size_t)row * D;
#pragma unroll
        for (int h = 0; h < 2; ++h) { const int c = 256 * pn + cl + 128 * h;
            if (xl) { const f32x4 x0 = __builtin_nontemporal_load((const f32x4*)(src + c)), x1 = __builtin_nontemporal_load((const f32x4*)(src + c + 4)); P.xo[8 * h] = x0[0]; P.xo[8 * h + 1] = x0[1]; P.xo[8 * h + 2] = x0[2]; P.xo[8 * h + 3] = x0[3]; P.xo[8 * h + 4] = x1[0]; P.xo[8 * h + 5] = x1[1]; P.xo[8 * h + 6] = x1[2]; P.xo[8 * h + 7] = x1[3]; }
            else unpack8(*(const u32x4*)(dst + c), P.xo + 8 * h); } }
    __device__ __forceinline__ void apply(int row, int pn, int cl, float* v0, float* v1, const EpiResPre& P) const {
        const int b = row < NL ? row >> 11 : 16; const float* g = mod + (size_t)b * 6144 + 2048 + 256 * pn + cl; bf16_t* dst = xb + (size_t)row * D;
#pragma unroll
        for (int h = 0; h < 2; ++h) { float* v = h ? v1 : v0; const int c = 256 * pn + cl + 128 * h;
            const f32x4 g0 = *(const f32x4*)(g + 128 * h), g1 = *(const f32x4*)(g + 128 * h + 4); float o[8];
#pragma unroll
            for (int i = 0; i < 4; ++i) { o[i] = P.xo[8 * h + i] + g0[i] * v[i]; o[4 + i] = P.xo[8 * h + 4 + i] + g1[i] * v[4 + i]; }
            store8_bf16(dst + c, o); } }
    __device__ __forceinline__ void operator()(int row, int pn, int cl, float* v0, float* v1) const { EpiResPre P; load(row, pn, cl, P); apply(row, pn, cl, v0, v1, P); }
};
struct EpiGU { bf16_t* O;
    __device__ __forceinline__ void operator()(int row, int pn, int cl, float* v0, float* v1) const {
        float a[8];
#pragma unroll
        for (int i = 0; i < 8; ++i) a[i] = v0[i] * __builtin_amdgcn_rcpf(1.f + __builtin_amdgcn_exp2f(-LOG2E * v0[i])) * v1[i];
        store8_bf16(O + (size_t)row * FF + 128 * pn + cl, a);
    } };
struct EpiY { bf16_t* O;
    __device__ __forceinline__ void operator()(int row, int pn, int cl, float* v0, float* v1) const {
        bf16_t* p = O + (size_t)row * D + 256 * pn + cl; store8_bf16(p, v0); store8_bf16(p + 128, v1);
    } };


struct EpiResPre;
namespace pg8 {
#define PG8_LAS __attribute__((address_space(3)))
typedef short bf16x8 __attribute__((ext_vector_type(8)));
constexpr int BM = 256, BK = 64, HALF = 128, HTB = HALF * BK * 2, STAGE_BYTES = 8 * HTB, NXCD = 8, WGM = 8;
__host__ __device__ __forceinline__ int lds_byte(int r, int c) { const int st = (r >> 4) * 2 + (c >> 5), rr = r & 15, cc = c & 31, ob = rr * 64 + cc * 2; return st * 1024 + (ob ^ (((ob >> 9) & 1) << 5)); }
__host__ __device__ __forceinline__ void stage_rc(int b, int& R, int& C) { const int st = b / 1024, sb = b % 1024, swz = sb ^ (((sb >> 9) & 1) << 5); R = (st >> 1) * 16 + swz / 64; C = (st & 1) * 32 + (swz % 64) / 2; }
__host__ __device__ __forceinline__ int perm32(int rho) { const int n = rho >> 4, i = rho & 15; return 8 * (i >> 2) + 4 * n + (i & 3); }
struct Unit { int pm, pn; };
struct Gemm { const bf16_t* A; const bf16_t* Bt; int K; const int* tile_e; size_t estride; const int* gather; };
__device__ __forceinline__ const char* unit_b(const Gemm& g, const Unit& u, size_t tstep) {
    const bf16_t* b = g.Bt; if (g.tile_e) b += (size_t)g.tile_e[u.pm] * g.estride; return (const char*)b + (size_t)u.pn * tstep; }
struct StaticOrder {
    int nM, nN, nwg, G, c;
    __device__ void init(int nM_, int nN_, int G_, int c_) { nM = nM_; nN = nN_; nwg = nM * nN; G = G_; c = c_; }
    __device__ bool next(int i, Unit& u) const {
        const long L = (long)i * G + c; if (L >= nwg) return false;
        int wgid = (int)L; { const int q = nwg / NXCD, r = nwg % NXCD, xcd = wgid % NXCD, off = wgid / NXCD; wgid = (xcd < r ? xcd * (q + 1) : r * (q + 1) + (xcd - r) * q) + off; }
        const int nig = WGM * nN, gid = wgid / nig, fm = gid * WGM, gsz = (nM - fm) < WGM ? (nM - fm) : WGM;
        u.pm = fm + ((wgid % nig) % gsz); u.pn = (wgid % nig) / gsz; return true;
    }
    __device__ __forceinline__ void a_ready(const Unit&) const {}
    __device__ __forceinline__ void done(const Unit&) const {}
};
template <class Epi> struct epi_has_prefetch { template <class T> static constexpr bool test(decltype(T::PREFETCH)*) { return T::PREFETCH; } template <class T> static constexpr bool test(...) { return false; } static constexpr bool value = test<Epi>(nullptr); };
template <class Epi>
__device__ __forceinline__ void run_epi(const f32x4 (&acc)[2][2][4][2], const Unit& u, int wr, int wc, int fr, int fq, const Epi& E) {
#pragma unroll
    for (int ai = 0; ai < 2; ++ai) {
        if constexpr (epi_has_prefetch<Epi>::value) {
            EpiResPre P[4];
#pragma unroll
            for (int m = 0; m < 4; ++m) E.load(u.pm * BM + ai * HALF + wr * 64 + m * 16 + fr, u.pn, wc * 32 + fq * 8, P[m]);
#pragma unroll
            for (int m = 0; m < 4; ++m) { const int row = u.pm * BM + ai * HALF + wr * 64 + m * 16 + fr; float v0[8], v1[8];
#pragma unroll
                for (int i = 0; i < 4; ++i) { v0[i] = acc[ai][0][m][0][i]; v0[4 + i] = acc[ai][0][m][1][i]; v1[i] = acc[ai][1][m][0][i]; v1[4 + i] = acc[ai][1][m][1][i]; }
                E.apply(row, u.pn, wc * 32 + fq * 8, v0, v1, P[m]); }
        } else {
#pragma unroll
            for (int m = 0; m < 4; ++m) { const int row = u.pm * BM + ai * HALF + wr * 64 + m * 16 + fr; float v0[8], v1[8];
#pragma unroll
                for (int i = 0; i < 4; ++i) { v0[i] = acc[ai][0][m][0][i]; v0[4 + i] = acc[ai][0][m][1][i]; v1[i] = acc[ai][1][m][0][i]; v1[4 + i] = acc[ai][1][m][1][i]; }
                E(row, u.pn, wc * 32 + fq * 8, v0, v1); }
        }
    }
}
template <class Epi, class Sched, bool ALIGN_EPI = false, bool SP2 = false>
__device__ __forceinline__ void gemm_phase(PG8_LAS unsigned char* lds, const Gemm g, const Sched& S, const Epi& E, const int tid_in) {
    const int tid = tid_in, wid = __builtin_amdgcn_readfirstlane(tid >> 6), lane = tid & 63, wr = wid >> 2, wc = wid & 3, fr = lane & 15, fq = lane >> 4;
    const int K = g.K, nt = K / BK;
    unsigned voffA[2], voffB[2];
#pragma unroll
    for (int i = 0; i < 2; ++i) { int R, C; stage_rc(tid * 16 + i * 8192, R, C); const int Rb = ((R & ~31) + perm32(R & 31));
        voffA[i] = (unsigned)(R * K + C) * 2u; voffB[i] = (unsigned)(Rb * K + C) * 2u; }
    unsigned voC[2][2], voN[2][2]; int gR[2], gC[2];
#pragma unroll
    for (int i = 0; i < 2; ++i) { int R, C; stage_rc(tid * 16 + i * 8192, R, C); gR[i] = R; gC[i] = C; voC[0][i] = voC[1][i] = voN[0][i] = voN[1][i] = voffA[i]; }
    const size_t kstep = (size_t)(BK * 2);
    const size_t hstep = (size_t)HALF * K * 2;
    const size_t tstep = 2 * hstep;
    const size_t ahs = g.gather ? 0 : hstep;
#define PG8_GATHER(vo, unit) do { if (g.gather) { _Pragma("unroll") for (int h_ = 0; h_ < 2; ++h_) _Pragma("unroll") for (int i_ = 0; i_ < 2; ++i_) { \
        const int tk_ = g.gather[(unit).pm * BM + h_ * HALF + gR[i_]]; (vo)[h_][i_] = (unsigned)(((unsigned)tk_ < (unsigned)NTOK ? tk_ : 0) * K + gC[i_]) * 2u; } } } while (0)
    const unsigned ldsw = (unsigned)wid * 1024u;
    const int aoff = lds_byte(wr * 64 + fr, fq * 8), boff = lds_byte(wc * 32 + fr, fq * 8);
#define PG8_SA(b, h) (((b) * 2 + (h)) * HTB)
#define PG8_SB(b, h) ((4 + (b) * 2 + (h)) * HTB)
#define PG8_STAGE(bufoff, gbase, voff) do { _Pragma("unroll") for (int _i = 0; _i < 2; ++_i) \
        __builtin_amdgcn_global_load_lds((const unsigned*)((const char*)(gbase) + (voff)[_i]), (PG8_LAS unsigned*)(lds + (bufoff) + ldsw + _i * 8192), 16, 0, 0); } while (0)
#define PG8_LDA(dst, b, h) do { _Pragma("unroll") for (int m = 0; m < 4; ++m) _Pragma("unroll") for (int k = 0; k < 2; ++k) dst[m][k] = *(const PG8_LAS bf16x8*)(lds + PG8_SA(b, h) + aoff + m * 2048 + k * 1024); } while (0)
#define PG8_LDB(dst, b, h) do { _Pragma("unroll") for (int n = 0; n < 2; ++n) _Pragma("unroll") for (int k = 0; k < 2; ++k) dst[n][k] = *(const PG8_LAS bf16x8*)(lds + PG8_SB(b, h) + boff + n * 2048 + k * 1024); } while (0)
#define PG8_MMA(ai, bj, At, Bt) do { __builtin_amdgcn_s_setprio(1); _Pragma("unroll") for (int m = 0; m < 4; ++m) _Pragma("unroll") for (int n = 0; n < 2; ++n) _Pragma("unroll") for (int k = 0; k < 2; ++k) \
        acc[ai][bj][m][n] = __builtin_amdgcn_mfma_f32_16x16x32_bf16(Bt[n][k], At[m][k], acc[ai][bj][m][n], 0, 0, 0); __builtin_amdgcn_s_setprio(0); } while (0)
#define PG8_WAIT_V(n) asm volatile("s_waitcnt vmcnt(" #n ")" ::: "memory")
#define PG8_WAIT_L(n) asm volatile("s_waitcnt lgkmcnt(" #n ")" ::: "memory")
#define PG8_BAR __builtin_amdgcn_s_barrier()
#define PG8_SCHED __builtin_amdgcn_sched_barrier(0)
    Unit cur, nxt; int ui = 0;
    if (!S.next(0, cur)) return;
    f32x4 acc[2][2][4][2];
#pragma unroll
    for (int a = 0; a < 2; ++a)
#pragma unroll
        for (int b = 0; b < 2; ++b)
#pragma unroll
            for (int m = 0; m < 4; ++m)
#pragma unroll
                for (int n = 0; n < 2; ++n) acc[a][b][m][n] = (f32x4){0.f, 0.f, 0.f, 0.f};
    bf16x8 At[4][2], B0[2][2], B1[2][2];
    const char* cA = g.gather ? (const char*)g.A : (const char*)g.A + (size_t)cur.pm * tstep; const char* cB = unit_b(g, cur, tstep);
    PG8_GATHER(voC, cur);
    S.a_ready(cur);
    if constexpr (SP2) {
        PG8_STAGE(PG8_SB(0, 0), cB, voffB); PG8_STAGE(PG8_SB(0, 1), cB + hstep, voffB); PG8_STAGE(PG8_SA(0, 0), cA, voC[0]); PG8_STAGE(PG8_SA(0, 1), cA + ahs, voC[1]);
        if (wr == 1) PG8_BAR;
        PG8_WAIT_V(2); PG8_BAR;
        PG8_STAGE(PG8_SB(1, 0), cB + kstep, voffB); PG8_STAGE(PG8_SA(1, 0), cA + kstep, voC[0]); PG8_STAGE(PG8_SB(1, 1), cB + hstep + kstep, voffB);
        PG8_WAIT_V(6); PG8_BAR;
    } else {
        PG8_STAGE(PG8_SB(0, 0), cB, voffB); PG8_STAGE(PG8_SA(0, 0), cA, voC[0]); PG8_STAGE(PG8_SB(0, 1), cB + hstep, voffB); PG8_STAGE(PG8_SA(0, 1), cA + ahs, voC[1]);
        if (wr == 1) PG8_BAR;
        PG8_WAIT_V(4); PG8_BAR;
        PG8_STAGE(PG8_SB(1, 0), cB + kstep, voffB); PG8_STAGE(PG8_SA(1, 0), cA + kstep, voC[0]); PG8_STAGE(PG8_SB(1, 1), cB + hstep + kstep, voffB);
        PG8_WAIT_V(6); PG8_BAR;
    }
    for (;;) {
        const bool has_next = S.next(ui + 1, nxt);
        const char* nA = (has_next && !g.gather) ? (const char*)g.A + (size_t)nxt.pm * tstep : cA; const char* nB = has_next ? unit_b(g, nxt, tstep) : cB;
        if (has_next) PG8_GATHER(voN, nxt);
        for (int t = 0; t < nt; t += 2) {
            const bool last = (t == nt - 2);
            const char* a1 = cA + (size_t)(t + 1) * kstep;
            const char* a2 = last ? nA : cA + (size_t)(t + 2) * kstep; const char* b2 = last ? nB : cB + (size_t)(t + 2) * kstep;
            const char* a3 = a2 + kstep; const char* b3 = b2 + kstep;
            unsigned v2[2][2];
#pragma unroll
            for (int h_ = 0; h_ < 2; ++h_)
#pragma unroll
                for (int i_ = 0; i_ < 2; ++i_) v2[h_][i_] = last ? voN[h_][i_] : voC[h_][i_];
            if (last && has_next) S.a_ready(nxt);
            if constexpr (SP2) {
            PG8_LDB(B0, 0, 0); PG8_LDB(B1, 0, 1); PG8_SCHED; PG8_LDA(At, 0, 0); PG8_STAGE(PG8_SA(1, 1), a1 + ahs, voC[1]);
            PG8_WAIT_V(8); PG8_WAIT_L(0); PG8_BAR; PG8_MMA(0, 0, At, B0); PG8_MMA(0, 1, At, B1); PG8_BAR; PG8_SCHED;
            PG8_LDA(At, 0, 1); PG8_STAGE(PG8_SB(0, 0), b2, voffB); PG8_STAGE(PG8_SB(0, 1), b2 + hstep, voffB); PG8_STAGE(PG8_SA(0, 0), a2, v2[0]);
            PG8_WAIT_V(8); PG8_WAIT_L(0); PG8_BAR; PG8_MMA(1, 0, At, B0); PG8_MMA(1, 1, At, B1); PG8_BAR; PG8_SCHED;
            PG8_LDB(B0, 1, 0); PG8_LDB(B1, 1, 1); PG8_SCHED; PG8_LDA(At, 1, 0); PG8_STAGE(PG8_SA(0, 1), a2 + ahs, v2[1]);
            PG8_WAIT_V(8); PG8_WAIT_L(0); PG8_BAR; PG8_MMA(0, 0, At, B0); PG8_MMA(0, 1, At, B1); PG8_BAR; PG8_SCHED;
            PG8_LDA(At, 1, 1); PG8_STAGE(PG8_SB(1, 0), b3, voffB); PG8_STAGE(PG8_SB(1, 1), b3 + hstep, voffB); PG8_STAGE(PG8_SA(1, 0), a3, v2[0]);
            PG8_WAIT_V(8); PG8_WAIT_L(0); PG8_BAR; PG8_MMA(1, 0, At, B0); PG8_MMA(1, 1, At, B1); PG8_BAR; PG8_SCHED;
            } else {
            PG8_LDB(B0, 0, 0); PG8_SCHED; PG8_LDA(At, 0, 0); PG8_STAGE(PG8_SA(1, 1), a1 + ahs, voC[1]);
            PG8_WAIT_L(8); PG8_BAR; PG8_WAIT_L(0); PG8_MMA(0, 0, At, B0); PG8_BAR; PG8_SCHED;
            PG8_LDB(B1, 0, 1); PG8_STAGE(PG8_SB(0, 0), b2, voffB);
            PG8_BAR; PG8_WAIT_L(0); PG8_MMA(0, 1, At, B1); PG8_BAR;
            PG8_LDA(At, 0, 1); PG8_STAGE(PG8_SA(0, 0), a2, v2[0]);
            PG8_BAR; PG8_WAIT_L(0); PG8_MMA(1, 0, At, B0); PG8_BAR; PG8_SCHED;
            PG8_STAGE(PG8_SB(0, 1), b2 + hstep, voffB);
            PG8_WAIT_V(6); PG8_BAR; PG8_MMA(1, 1, At, B1); PG8_BAR;
            PG8_LDB(B0, 1, 0); PG8_SCHED; PG8_LDA(At, 1, 0); PG8_STAGE(PG8_SA(0, 1), a2 + ahs, v2[1]);
            PG8_WAIT_L(8); PG8_BAR; PG8_WAIT_L(0); PG8_MMA(0, 0, At, B0); PG8_BAR; PG8_SCHED;
            PG8_LDB(B1, 1, 1); PG8_STAGE(PG8_SB(1, 0), b3, voffB);
            PG8_BAR; PG8_WAIT_L(0); PG8_MMA(0, 1, At, B1); PG8_BAR;
            PG8_LDA(At, 1, 1); PG8_STAGE(PG8_SA(1, 0), a3, v2[0]);
            PG8_BAR; PG8_WAIT_L(0); PG8_MMA(1, 0, At, B0); PG8_BAR; PG8_SCHED;
            PG8_STAGE(PG8_SB(1, 1), b3 + hstep, voffB);
            PG8_WAIT_V(6); PG8_BAR; PG8_MMA(1, 1, At, B1); PG8_BAR;
            }
        }
        if constexpr (ALIGN_EPI) { if (wr == 0) PG8_BAR; }
        run_epi(acc, cur, wr, wc, fr, fq, E); S.done(cur);
        if (!has_next) break;
#pragma unroll
        for (int a = 0; a < 2; ++a)
#pragma unroll
            for (int b = 0; b < 2; ++b)
#pragma unroll
                for (int m = 0; m < 4; ++m)
#pragma unroll
                    for (int n = 0; n < 2; ++n) acc[a][b][m][n] = (f32x4){0.f, 0.f, 0.f, 0.f};
        cur = nxt; cA = nA; cB = nB; ++ui;
#pragma unroll
        for (int h_ = 0; h_ < 2; ++h_)
#pragma unroll
            for (int i_ = 0; i_ < 2; ++i_) voC[h_][i_] = voN[h_][i_];
        if constexpr (ALIGN_EPI) { if (wr == 1) PG8_BAR; }
    }
    PG8_WAIT_V(0);
    if constexpr (!ALIGN_EPI) { if (wr == 0) PG8_BAR; }
    PG8_BAR;
#undef PG8_GATHER
#undef PG8_SA
#undef PG8_SB
#undef PG8_STAGE
#undef PG8_LDA
#undef PG8_LDB
#undef PG8_MMA
#undef PG8_WAIT_V
#undef PG8_WAIT_L
#undef PG8_BAR
#undef PG8_SCHED
}
}


#ifndef GEMM_NAIVE
#define GEMM_NAIVE 0
#endif
template <class Epi>
__device__ __forceinline__ void gemm_run(Ctx& F, const GemmDesc g, const Epi& E) {
#if GEMM_NAIVE
    gemm_naive(F, g, E);
#else
    pg8::Gemm pg{g.A, g.Bt, g.K, g.tile_e, g.estride, g.gather}; pg8::StaticOrder S; S.init(g.nM, g.nN, F.nblk, F.blk);
    pg8::gemm_phase<Epi, pg8::StaticOrder, true, true>(F.lds, pg, S, E, F.tid);
    __syncthreads();
#endif
}
__device__ __forceinline__ void load_vec64(const bf16_t* p, float* v) {
#pragma unroll
    for (int j = 0; j < 8; ++j) unpack8(*(const u32x4*)(p + 8 * j), v + 8 * j);
}
__device__ __forceinline__ float dot64(const float* q, const bf16_t* kp) {
    float s = 0.f;
#pragma unroll
    for (int j = 0; j < 8; ++j) { float k[8]; unpack8(*(const u32x4*)(kp + 8 * j), k);
#pragma unroll
        for (int i = 0; i < 8; ++i) s += q[8 * j + i] * k[i]; }
    return s;
}
__device__ __forceinline__ void axpy64(float* o, float al, float p, const bf16_t* vp) {
#pragma unroll
    for (int j = 0; j < 8; ++j) { float v[8]; unpack8(*(const u32x4*)(vp + 8 * j), v);
#pragma unroll
        for (int i = 0; i < 8; ++i) o[8 * j + i] = o[8 * j + i] * al + p * v[i]; }
}
__device__ __forceinline__ void attend(const float* q, float* o, float& m, float& l, const bf16_t* kp, const bf16_t* vp, float bias) {
    const float s = bias + dot64(q, kp);
    const float mn = fmaxf(m, s), al = exp2f(m - mn), p = exp2f(s - mn); l = l * al + p; m = mn;
    axpy64(o, al, p, vp);
}
__device__ __forceinline__ void store_vec64_scaled(bf16_t* p, const float* o, float sc) {
#pragma unroll
    for (int j = 0; j < 8; ++j) { float t[8];
#pragma unroll
        for (int i = 0; i < 8; ++i) t[i] = o[8 * j + i] * sc;
        store8_bf16(p + 8 * j, t); }
}
__device__ __forceinline__ void naive_retention(Ctx& F) {
    const bf16_t* QKV = (const bf16_t*)(F.ws + WS_QKV); bf16_t* MIX = (bf16_t*)(F.ws + WS_MIX);
    const int total = NB * 8 * 2304;
    for (int idx = F.blk * NTHREADS + F.tid; idx < total; idx += F.nblk * NTHREADS) {
        const int n = idx % 2304, bh = idx / 2304, h = bh & 7, b = bh >> 3;
        const float df = F.in[I_RETDEC][h], db = F.in[I_RETDEC][8 + h];
        const float lgf = log1pf(-exp2f(-df)) * LOG2E, lgb = log1pf(-exp2f(-db)) * LOG2E;
        const size_t rowc = (size_t)NL + b * CTXL, rowl = (size_t)b * SEQ;
        const size_t myrow = n < 256 ? rowc + n : rowl + (n - 256);
        float q[64], o[64]; load_vec64(QKV + myrow * ABIN + h * 64, q);
#pragma unroll
        for (int i = 0; i < 64; ++i) o[i] = 0.f;
        for (int m = 0; m < 2304; ++m) {
            float w = 0.f;
            if (n < 256) { if (m < 256) { if (m <= n) w += exp2f(lgf * (float)(n - m)); if (m >= n) w += exp2f(lgb * (float)(m - n)); } else continue; }
            else { const int t = n - 256;
                if (m < 256) w = exp2f(lgf * (float)(n - m)) + exp2f(lgb * (float)(2048 - t + m));
                else { const int t2 = m - 256; if (t2 <= t) w += exp2f(lgf * (float)(t - t2)); if (t2 >= t) w += exp2f(lgb * (float)(t2 - t)); } }
            const size_t r = m < 256 ? rowc + m : rowl + (m - 256);
            const float s = w * dot64(q, QKV + r * ABIN + 512 + h * 64);
            axpy64(o, 1.f, s, QKV + r * ABIN + 1024 + h * 64);
        }
        float mu = 0.f;
#pragma unroll
        for (int i = 0; i < 64; ++i) mu += o[i];
        mu *= (1.f / 64.f); float var = 0.f;
#pragma unroll
        for (int i = 0; i < 64; ++i) { o[i] -= mu; var += o[i] * o[i]; }
        const float rs = rsqrtf(var * (1.f / 64.f) + 1e-5f);
#pragma unroll
        for (int j = 0; j < 8; ++j) { float g[8], t[8]; unpack8(*(const u32x4*)(QKV + myrow * ABIN + 1536 + h * 64 + 8 * j), g);
#pragma unroll
            for (int i = 0; i < 8; ++i) t[i] = o[8 * j + i] * rs * F.in[I_RETGN][h * 64 + 8 * j + i] * silu_f(g[i]);
            store8_bf16(MIX + myrow * D + h * 64 + 8 * j, t); }
    }
}
__device__ __forceinline__ void naive_na(Ctx& F) {
    const bf16_t* QKV = (const bf16_t*)(F.ws + WS_QKV); bf16_t* MIX = (bf16_t*)(F.ws + WS_MIX);
    const int total = NB * 8 * 2304;
    for (int idx = F.blk * NTHREADS + F.tid; idx < total; idx += F.nblk * NTHREADS) {
        const int n = idx % 2304, bh = idx / 2304, h = bh & 7, b = bh >> 3;
        const size_t rowc = (size_t)NL + b * CTXL, rowl = (size_t)b * SEQ;
        const size_t myrow = n < 2048 ? rowl + n : rowc + (n - 2048);
        float q[64], o[64]; load_vec64(QKV + myrow * ABIN + 2048 + h * 64, q);
#pragma unroll
        for (int i = 0; i < 64; ++i) o[i] = 0.f;
        float m = -1e30f, l = 0.f;
        if (n < 2048) { const int r = n >> 6, c = n & 63; int rs = r - 4; rs = rs < 0 ? 0 : (rs > 24 ? 24 : rs); int win = c - 8; win = win < 0 ? 0 : (win > 48 ? 48 : win);
            const float* rpb = F.in[I_RPB] + (size_t)h * 15 * 31;
            for (int i = 0; i < 8; ++i) for (int j = 0; j < 16; ++j) { const int kr = rs + i, kc = win + j; const size_t kro = rowl + kr * 64 + kc;
                attend(q, o, m, l, QKV + kro * ABIN + 2560 + h * 64, QKV + kro * ABIN + 3072 + h * 64, rpb[(kr - r + 7) * 31 + (kc - c + 15)] * LOG2E); } }
        for (int j = 0; j < 256; ++j) { const size_t kro = rowc + j; attend(q, o, m, l, QKV + kro * ABIN + 2560 + h * 64, QKV + kro * ABIN + 3072 + h * 64, 0.f); }
        store_vec64_scaled(MIX + myrow * D + 512 + h * 64, o, 1.f / l);
    }
}
__device__ __forceinline__ void naive_swa(Ctx& F) {
    const bf16_t* QKV = (const bf16_t*)(F.ws + WS_QKV); bf16_t* MIX = (bf16_t*)(F.ws + WS_MIX);
    const int total = NB * 16 * 2048;
    for (int idx = F.blk * NTHREADS + F.tid; idx < total; idx += F.nblk * NTHREADS) {
        const int t = idx & 2047, bh = idx >> 11, h = bh & 15, b = bh >> 4, kv = h >> 2;
        const size_t rowc = (size_t)NL + b * CTXL, rowl = (size_t)b * SEQ;
        float q[64], o[64]; load_vec64(QKV + (rowl + t) * SWAIN + h * 64, q);
#pragma unroll
        for (int i = 0; i < 64; ++i) o[i] = 0.f;
        float m = F.in[I_SINK][h] * LOG2E, l = 1.f;
        const int lo = t - 128 < 0 ? 0 : t - 128, hi = t + 128 > 2047 ? 2047 : t + 128;
        for (int j = lo; j <= hi; ++j) attend(q, o, m, l, QKV + (rowl + j) * SWAIN + 1024 + kv * 64, QKV + (rowl + j) * SWAIN + 1280 + kv * 64, 0.f);
        for (int j = 0; j < 256; ++j) attend(q, o, m, l, QKV + (rowc + j) * SWAIN + 1024 + kv * 64, QKV + (rowc + j) * SWAIN + 1280 + kv * 64, 0.f);
        store_vec64_scaled(MIX + (rowl + t) * D + h * 64, o, 1.f / l);
    }
}


typedef float f32x16 __attribute__((ext_vector_type(16)));
typedef short s16x4 __attribute__((ext_vector_type(4)));
__device__ __forceinline__ int crow(int r, int hi) { return (r & 3) + 8 * (r >> 2) + 4 * hi; }
__device__ __forceinline__ s16x4 vtr(const LAS char* p) { return __builtin_bit_cast(s16x4, __builtin_amdgcn_ds_read_tr16_b64_v4i16((LAS s16x4*)p)); }
__device__ __forceinline__ unsigned cvtpk(float lo, float hi) { typedef float f2 __attribute__((ext_vector_type(2))); typedef __bf16 b2 __attribute__((ext_vector_type(2)));
    f2 v = {lo, hi}; b2 b = __builtin_convertvector(v, b2); return __builtin_bit_cast(unsigned, b); }
__device__ __forceinline__ float swapmax(float v) { auto rr = __builtin_amdgcn_permlane32_swap(__float_as_uint(v), __float_as_uint(v), false, false); return fmaxf(__uint_as_float(rr[0]), __uint_as_float(rr[1])); }
__device__ __forceinline__ float swapsum(float v) { auto rr = __builtin_amdgcn_permlane32_swap(__float_as_uint(v), __float_as_uint(v), false, false); return __uint_as_float(rr[0]) + __uint_as_float(rr[1]); }
constexpr int FA_WAVE_LDS = 15104;
constexpr int FA_V = 8192, FA_SCR = 12288, FA_BIAS = 12544;

struct FaTile { unsigned k; int mode, p0, p1, p2; };
__device__ __forceinline__ void fa_uniform(FaTile& T) { T.k = __builtin_amdgcn_readfirstlane(T.k); T.mode = __builtin_amdgcn_readfirstlane(T.mode); T.p0 = __builtin_amdgcn_readfirstlane(T.p0); T.p1 = __builtin_amdgcn_readfirstlane(T.p1); T.p2 = __builtin_amdgcn_readfirstlane(T.p2); }
struct FaAcc { f32x16 o[2][2]; float m[2], l[2]; };

__device__ __forceinline__ void fa_load_k(const bf16_t* base, const FaTile& T, int ld, int lane, bf16x8* kf) {
    const int r32 = lane & 31, hi = lane >> 5; const bf16_t* p = base + T.k;
#pragma unroll
    for (int ds = 0; ds < 4; ++ds) kf[ds] = *(const bf16x8*)(p + (unsigned)(r32 * ld + 16 * ds + 8 * hi));
}
__device__ __forceinline__ void fa_load_v(const bf16_t* base, const FaTile& T, int ld, int lane, u32x4* vr) {
    const bf16_t* p = base + T.k;
#pragma unroll
    for (int i = 0; i < 4; ++i) { const int c = lane + 64 * i; vr[i] = *(const u32x4*)(p + (unsigned)((c >> 3) * ld + (c & 7) * 8)); }
}
__device__ __forceinline__ void fa_tile(const FaTile& T, const bf16x8* kf, const u32x4* vr, FaAcc& A, LAS char* wl, int lane) {
    const int r32 = lane & 31, hi = lane >> 5;
    LAS float* scr = (LAS float*)(wl + FA_SCR); const LAS float* bias = (const LAS float*)(wl + FA_BIAS);
    bf16x8 pf[2][2];
#pragma unroll
    for (int qb = 0; qb < 2; ++qb) {
        f32x16 sc = f32x16{};
#pragma unroll
        for (int ds = 0; ds < 4; ++ds) { const bf16x8 qf = *(const LAS bf16x8*)(wl + (qb * 4 + ds) * 1024 + lane * 16); sc = __builtin_amdgcn_mfma_f32_32x32x16_bf16(kf[ds], qf, sc, 0, 0, 0); }
        if (T.mode == 1) {
            const int qr = T.p2 + 2 * qb + (r32 >> 4), c = T.p1 + (r32 & 15); int ks = T.p1 - 8; ks = ks < 0 ? 0 : (ks > 32 ? 32 : ks);
            int win = c - 8; win = win < 0 ? 0 : (win > 48 ? 48 : win); int rsq = qr - 4; rsq = rsq < 0 ? 0 : (rsq > 24 ? 24 : rsq);
            const bool rowok = (unsigned)(T.p0 - rsq) < 8u;
            const int lb = ks + 4 * hi - c + 15, vb = lb - (win - c + 15);
            const LAS float* bp = bias + 48 + (T.p0 - qr + 7) * 31 + lb;
#pragma unroll
            for (int r = 0; r < 16; ++r) { const int cr = (r & 3) + 8 * (r >> 2); const bool ok = rowok && (unsigned)(vb + cr) < 16u; const float bv = bp[cr]; sc[r] = ok ? sc[r] + bv : -INFINITY; }
        } else if (T.mode == 2) { const int base = T.p0 - (32 * qb + r32);
#pragma unroll
            for (int r = 0; r < 16; ++r) { const int d = base + crow(r, hi); if (d > 128 || d < -128) sc[r] = -INFINITY; }
        }
        float tm = sc[0];
#pragma unroll
        for (int r = 1; r < 16; ++r) tm = fmaxf(tm, sc[r]);
        tm = swapmax(tm);
        if (__any(tm > A.m[qb] + 8.f)) {
            const float mn = fmaxf(A.m[qb], tm), al = __builtin_amdgcn_exp2f(A.m[qb] - mn); A.m[qb] = mn; A.l[qb] *= al;
            if (hi == 0) scr[32 * qb + r32] = al;
#pragma unroll
            for (int r = 0; r < 16; ++r) { const float f = scr[32 * qb + crow(r, hi)]; A.o[qb][0][r] *= f; A.o[qb][1][r] *= f; }
        }
        float ps = 0.f; const float mm = A.m[qb];
#pragma unroll
        for (int r = 0; r < 16; ++r) { const float p = __builtin_amdgcn_exp2f(sc[r] - mm); sc[r] = p; ps += p; }
        A.l[qb] += ps;
#pragma unroll
        for (int s2 = 0; s2 < 2; ++s2) { u32x4 w; w.x = cvtpk(sc[8 * s2], sc[8 * s2 + 1]); w.y = cvtpk(sc[8 * s2 + 2], sc[8 * s2 + 3]);
            w.z = cvtpk(sc[8 * s2 + 4], sc[8 * s2 + 5]); w.w = cvtpk(sc[8 * s2 + 6], sc[8 * s2 + 7]); pf[qb][s2] = __builtin_bit_cast(bf16x8, w); }
    }
#pragma unroll
    for (int i = 0; i < 4; ++i) { const int c = lane + 64 * i, key = c >> 3, pc = c & 7; *(LAS u32x4*)(wl + FA_V + (pc >> 2) * 2048 + key * 64 + (pc & 3) * 16) = vr[i]; }
    const LAS char* vb = wl + FA_V + (4 * hi + ((lane & 15) >> 2)) * 64 + (16 * ((lane >> 4) & 1) + 4 * (lane & 3)) * 2;
#pragma unroll
    for (int nb = 0; nb < 2; ++nb)
#pragma unroll
        for (int s2 = 0; s2 < 2; ++s2) { const s16x4 lo = vtr(vb + nb * 2048 + s2 * 1024), hh = vtr(vb + nb * 2048 + s2 * 1024 + 512);
            const bf16x8 vf = {lo[0], lo[1], lo[2], lo[3], hh[0], hh[1], hh[2], hh[3]};
            A.o[0][nb] = __builtin_amdgcn_mfma_f32_32x32x16_bf16(pf[0][s2], vf, A.o[0][nb], 0, 0, 0);
            A.o[1][nb] = __builtin_amdgcn_mfma_f32_32x32x16_bf16(pf[1][s2], vf, A.o[1][nb], 0, 0, 0); }
}
template <class TL, class RM>
__device__ __forceinline__ void fa_unit(const TL& tl, const RM& rm, int nt, const bf16_t* q, int ldq, const bf16_t* kbase, const bf16_t* vbase, int ldkv, bf16_t* out, int ldo, float m0, float l0, LAS char* wl, int lane_in) {
    int lane = lane_in; asm volatile("" : "+v"(lane));
    int r32 = lane & 31, hi = lane >> 5;
#pragma unroll
    for (int qb = 0; qb < 2; ++qb)
#pragma unroll
        for (int ds = 0; ds < 4; ++ds) { const bf16x8 qf = *(const bf16x8*)(q + (size_t)rm(qb, r32) * ldq + 16 * ds + 8 * hi); *(LAS bf16x8*)(wl + (qb * 4 + ds) * 1024 + lane * 16) = qf; }
    FaAcc A;
#pragma unroll
    for (int qb = 0; qb < 2; ++qb) { A.o[qb][0] = f32x16{}; A.o[qb][1] = f32x16{}; A.m[qb] = m0; A.l[qb] = hi == 0 ? l0 : 0.f; }
    FaTile T, Tn; bf16x8 kf[4], kn[4]; u32x4 vr[4];
    tl(0, T); fa_uniform(T); fa_load_k(kbase, T, ldkv, lane, kf);
    for (int t = 0; t < nt; ++t) {
        fa_load_v(vbase, T, ldkv, lane, vr);
        tl(t + 1 < nt ? t + 1 : t, Tn); fa_uniform(Tn); fa_load_k(kbase, Tn, ldkv, lane, kn);
        fa_tile(T, kf, vr, A, wl, lane);
        T = Tn;
#pragma unroll
        for (int i = 0; i < 4; ++i) kf[i] = kn[i];
    }
    asm volatile("" : "+v"(lane)); r32 = lane & 31; hi = lane >> 5;
    LAS float* scr = (LAS float*)(wl + FA_SCR); LAS bf16_t* stg = (LAS bf16_t*)wl;
#pragma unroll
    for (int qb = 0; qb < 2; ++qb) { const float lt = swapsum(A.l[qb]); if (hi == 0) scr[32 * qb + r32] = 1.f / lt; }
    asm volatile("s_waitcnt lgkmcnt(0)" ::: "memory");
#pragma unroll
    for (int qb = 0; qb < 2; ++qb)
#pragma unroll
        for (int r = 0; r < 16; ++r) { const int row = 32 * qb + crow(r, hi); const float f = scr[row];
            stg[row * 64 + r32] = (bf16_t)f2bf(A.o[qb][0][r] * f); stg[row * 64 + 32 + r32] = (bf16_t)f2bf(A.o[qb][1][r] * f); }
    asm volatile("s_waitcnt lgkmcnt(0)" ::: "memory");
#pragma unroll
    for (int it = 0; it < 8; ++it) { const int row = it * 8 + (lane >> 3), ch = lane & 7; const u32x4 v = *(const LAS u32x4*)(wl + row * 128 + ch * 16); *(u32x4*)(out + (size_t)rm(row >> 5, row & 31) * ldo + ch * 8) = v; }
    asm volatile("s_waitcnt lgkmcnt(0)" ::: "memory");
}

struct RowSeq { __device__ __forceinline__ int operator()(int qb, int r32) const { return 32 * qb + r32; } };
struct RowQuad { int c0; __device__ __forceinline__ int operator()(int qb, int r32) const { return (2 * qb + (r32 >> 4)) * 64 + c0 + (r32 & 15); } };
struct NaTiles { unsigned kl, kc; int kr0, nloc, c0, R0;
    __device__ __forceinline__ void operator()(int t, FaTile& T) const {
        if (t < nloc) { int ks = c0 - 8; ks = ks < 0 ? 0 : (ks > 32 ? 32 : ks); T.k = kl + (unsigned)((kr0 + t) * 64 + ks) * ABIN; T.mode = 1; T.p0 = kr0 + t; T.p1 = c0; T.p2 = R0; }
        else { T.k = kc + (unsigned)(32 * (t - nloc)) * ABIN; T.mode = 0; T.p0 = 0; T.p1 = 0; T.p2 = 0; } } };
struct CtxTiles { unsigned kc; int ld;
    __device__ __forceinline__ void operator()(int t, FaTile& T) const { T.k = kc + (unsigned)(32 * t) * ld; T.mode = 0; T.p0 = 0; T.p1 = 0; T.p2 = 0; } };
__device__ __forceinline__ void na_unit(Ctx& F, int u, LAS char* wl) {
    const bf16_t* QKV = (const bf16_t*)(F.ws + WS_QKV); bf16_t* MIX = (bf16_t*)(F.ws + WS_MIX);
    if (u < 4096) { const int j = u & 3, Rq = (u >> 2) & 7, bh = u >> 5, h = bh & 7, b = bh >> 3, R0 = 4 * Rq, c0 = 16 * j;
        LAS float* bias = (LAS float*)(wl + FA_BIAS); const float* rpb = F.in[I_RPB] + (size_t)h * 465;
        for (int i = F.lane; i < 465; i += 64) bias[48 + i] = rpb[i] * LOG2E;
        asm volatile("s_waitcnt lgkmcnt(0)" ::: "memory");
        int kr0 = R0 - 4; kr0 = kr0 < 0 ? 0 : (kr0 > 24 ? 24 : kr0); int rl = R0 + 3 - 4; rl = rl < 0 ? 0 : (rl > 24 ? 24 : rl); const int nloc = rl + 7 - kr0 + 1;
        const size_t rowl = (size_t)b * SEQ, rowc = (size_t)NL + b * CTXL;
        NaTiles tl{(unsigned)(rowl * ABIN + 2560 + h * 64), (unsigned)(rowc * ABIN + 2560 + h * 64), kr0, nloc, c0, R0};
        fa_unit(tl, RowQuad{c0}, nloc + 8, QKV + (rowl + R0 * 64) * ABIN + 2048 + h * 64, ABIN, QKV, QKV + 512, ABIN, MIX + (rowl + R0 * 64) * D + 512 + h * 64, D, -1e30f, 0.f, wl, F.lane);
    } else { const int v = u - 4096, qb = v & 3, bh = v >> 2, h = bh & 7, b = bh >> 3; const size_t rowc = (size_t)NL + b * CTXL;
        CtxTiles tl{(unsigned)(rowc * ABIN + 2560 + h * 64), ABIN};
        fa_unit(tl, RowSeq{}, 8, QKV + (rowc + qb * 64) * ABIN + 2048 + h * 64, ABIN, QKV, QKV + 512, ABIN, MIX + (rowc + qb * 64) * D + 512 + h * 64, D, -1e30f, 0.f, wl, F.lane);
    }
}
struct SwaTiles { unsigned kl, kc; int t0, first, nloc;
    __device__ __forceinline__ void operator()(int t, FaTile& T) const {
        if (t < nloc) { const int ks = first + 32 * t; T.k = kl + (unsigned)ks * SWAIN; const bool inner = (ks >= t0 - 65) && (ks + 31 <= t0 + 128); T.mode = inner ? 0 : 2; T.p0 = ks - t0; T.p1 = 0; T.p2 = 0; }
        else { T.k = kc + (unsigned)(32 * (t - nloc)) * SWAIN; T.mode = 0; T.p0 = 0; T.p1 = 0; T.p2 = 0; } } };
__device__ __forceinline__ void swa_unit(Ctx& F, int u, LAS char* wl) {
    const bf16_t* QKV = (const bf16_t*)(F.ws + WS_QKV); bf16_t* MIX = (bf16_t*)(F.ws + WS_MIX);
    const int g = u & 3, qblk = (u >> 2) & 31, kv = (u >> 7) & 3, b = u >> 9, h = kv * 4 + g, t0 = qblk * 64;
    const size_t rowl = (size_t)b * SEQ, rowc = (size_t)NL + b * CTXL;
    int lo = t0 - 128; lo = lo < 0 ? 0 : lo; int hi = t0 + 192; hi = hi > SEQ ? SEQ : hi;
    SwaTiles tl{(unsigned)(rowl * SWAIN + 1024 + kv * 64), (unsigned)(rowc * SWAIN + 1024 + kv * 64), t0, lo, (hi - lo) >> 5};
    fa_unit(tl, RowSeq{}, tl.nloc + 8, QKV + (rowl + t0) * SWAIN + h * 64, SWAIN, QKV, QKV + 256, SWAIN, MIX + (rowl + t0) * D + h * 64, D, F.in[I_SINK][h] * LOG2E, 1.f, wl, F.lane);
}
__device__ __forceinline__ void phase_na(Ctx& F) {
    LAS char* wl = (LAS char*)F.lds + F.wave * FA_WAVE_LDS;
    unsigned* q = (unsigned*)(F.ws + WS_CTL) + 16;
    for (;;) { unsigned u = 0; if (F.lane == 0) u = atomicAdd(q, 1u); u = __builtin_amdgcn_readfirstlane(u); if (u >= 4096u + 512u) break; na_unit(F, (int)u, wl); }
}
__device__ __forceinline__ void phase_swa(Ctx& F) {
    LAS char* wl = (LAS char*)F.lds + F.wave * FA_WAVE_LDS;
    for (int u = F.blk * NWAVES + F.wave; u < 8192; u += F.nblk * NWAVES) swa_unit(F, u, wl);
}

constexpr size_t WS_SB = WS_Y;
__device__ __forceinline__ bf16x8 trfrag_nat(const LAS char* base) {
    const s16x4 lo = vtr(base), hh = vtr(base + 256); return (bf16x8){lo[0], lo[1], lo[2], lo[3], hh[0], hh[1], hh[2], hh[3]}; }
__device__ __forceinline__ bf16x8 trfrag_acc(const LAS char* base) {
    const s16x4 lo = vtr(base), hh = vtr(base + 512); return (bf16x8){lo[0], lo[1], lo[2], lo[3], hh[0], hh[1], hh[2], hh[3]}; }
__device__ __forceinline__ u32x4 scale8(const u32x4 w, float f) { float t[8]; unpack8(w, t); u32x4 o; o.x = pk2(t[0] * f, t[1] * f); o.y = pk2(t[2] * f, t[3] * f); o.z = pk2(t[4] * f, t[5] * f); o.w = pk2(t[6] * f, t[7] * f); return o; }

__device__ __forceinline__ void ret_unit(Ctx& F, int bh) {
    const int b = bh >> 3, h = bh & 7;
    int lane = F.lane; asm volatile("" : "+v"(lane));
    const int wave = F.wave, r32 = lane & 31, hi = lane >> 5, grp = wave >> 2, wq = wave & 3, t4 = (wave & 3) * 64 + lane;
    const float lgf = log1pf(-exp2f(-F.in[I_RETDEC][h])) * LOG2E, lgb = log1pf(-exp2f(-F.in[I_RETDEC][8 + h])) * LOG2E;
    const bf16_t* QKV = (const bf16_t*)(F.ws + WS_QKV); bf16_t* MIX = (bf16_t*)(F.ws + WS_MIX);
    const size_t rowl = (size_t)b * SEQ, rowc = (size_t)NL + b * CTXL;
    bf16_t* SB = (bf16_t*)(F.ws + WS_SB) + (size_t)bh * 2 * 18 * 4096;
    LAS char* L = (LAS char*)F.lds;
    const int trq = (lane & 15) >> 2, trp = lane & 3, trg = (lane >> 4) & 1;
    const int troff = trq * 64 + (16 * trg + 4 * trp) * 2;
    LAS float* gnl = (LAS float*)(L + 135168);
    if (F.tid < 64) gnl[F.tid] = F.in[I_RETGN][h * 64 + F.tid];
    {
        LAS char* Kd = L + grp * 32768; LAS char* Vt = Kd + 16384;
        const float lg = grp ? lgb : lgf, g128 = __builtin_amdgcn_exp2f(lg * 128.f);
        const int dkb = wq >> 1, dvb = wq & 1;
        f32x16 st = f32x16{};
        for (int i = 0; i < 18; ++i) {
            const int seq = grp ? (i < 2 ? 1 - i : 19 - i) : i;
            { bf16_t* sp = SB + (size_t)(grp * 18 + seq) * 4096;
#pragma unroll
              for (int r = 0; r < 16; ++r) sp[(32 * dkb + crow(r, hi)) * 64 + 32 * dvb + r32] = (bf16_t)f2bf(st[r]); }
            if (i == 17) break;
            const size_t row0 = seq < 2 ? rowc + 128 * seq : rowl + 128 * (seq - 2);
#pragma unroll
            for (int j = 0; j < 4; ++j) { const int p = t4 + 256 * j, row = p >> 3, pc = p & 7;
                const u32x4 kv = *(const u32x4*)(QKV + (row0 + row) * ABIN + 512 + h * 64 + pc * 8), vv = *(const u32x4*)(QKV + (row0 + row) * ABIN + 1024 + h * 64 + pc * 8);
                const float dec = __builtin_amdgcn_exp2f(lg * (float)(grp ? row : 127 - row));
                const int off = (pc >> 2) * 8192 + row * 64 + (pc & 3) * 16;
                *(LAS u32x4*)(Kd + off) = scale8(kv, dec); *(LAS u32x4*)(Vt + off) = vv; }
            asm volatile("s_waitcnt lgkmcnt(0)" ::: "memory"); __syncthreads();
#pragma unroll
            for (int r = 0; r < 16; ++r) st[r] *= g128;
#pragma unroll
            for (int s2 = 0; s2 < 8; ++s2) { const int ro = (16 * s2 + 8 * hi) * 64 + troff;
                const bf16x8 af = trfrag_nat(Kd + dkb * 8192 + ro), bf = trfrag_nat(Vt + dvb * 8192 + ro);
                st = __builtin_amdgcn_mfma_f32_32x32x16_bf16(af, bf, st, 0, 0, 0); }
            asm volatile("s_waitcnt lgkmcnt(0)" ::: "memory"); __syncthreads();
        }
    }
    asm volatile("s_waitcnt vmcnt(0)" ::: "memory"); __syncthreads();
    for (int rd = 0; rd < 9; ++rd) {
        const int seq = 2 * rd + grp;
        const size_t row0 = seq < 2 ? rowc + 128 * seq : rowl + 128 * (seq - 2);
        LAS char* Vt = L + grp * 16384; LAS char* Sf = L + 32768 + grp * 16384; LAS char* Sbk = Sf + 8192;
#pragma unroll
        for (int j = 0; j < 4; ++j) { const int p = t4 + 256 * j, row = p >> 3, pc = p & 7;
            *(LAS u32x4*)(Vt + (pc >> 2) * 8192 + row * 64 + (pc & 3) * 16) = *(const u32x4*)(QKV + (row0 + row) * ABIN + 1024 + h * 64 + pc * 8); }
#pragma unroll
        for (int j = 0; j < 4; ++j) { const int p = t4 + 256 * j, d = j >> 1, pp = p & 511, row = pp >> 3, pc = pp & 7;
            *(LAS u32x4*)((d ? Sbk : Sf) + (pc >> 2) * 4096 + row * 64 + (pc & 3) * 16) = *(const u32x4*)(SB + (size_t)(d * 18 + seq) * 4096 + row * 64 + pc * 8); }
        bf16x8 qf[4], kfa[4][4];
#pragma unroll
        for (int ds = 0; ds < 4; ++ds) qf[ds] = *(const bf16x8*)(QKV + (row0 + 32 * wq + r32) * ABIN + h * 64 + 16 * ds + 8 * hi);
#pragma unroll
        for (int kb = 0; kb < 4; ++kb)
#pragma unroll
            for (int ds = 0; ds < 4; ++ds) kfa[kb][ds] = *(const bf16x8*)(QKV + (row0 + 32 * kb + r32) * ABIN + 512 + h * 64 + 16 * ds + 8 * hi);
        asm volatile("s_waitcnt lgkmcnt(0)" ::: "memory"); __syncthreads();
        f32x16 oi[2], of[2], ob[2];
#pragma unroll
        for (int nb = 0; nb < 2; ++nb) { oi[nb] = f32x16{}; of[nb] = f32x16{}; ob[nb] = f32x16{}; }
        const int nq = 32 * wq + r32;
#pragma unroll
        for (int kb = 0; kb < 4; ++kb) {
            f32x16 sc = f32x16{};
#pragma unroll
            for (int ds = 0; ds < 4; ++ds) sc = __builtin_amdgcn_mfma_f32_32x32x16_bf16(kfa[kb][ds], qf[ds], sc, 0, 0, 0);
#pragma unroll
            for (int r = 0; r < 16; ++r) { const int d = nq - (32 * kb + crow(r, hi)); const float e = __builtin_amdgcn_exp2f((d > 0 ? lgf : -lgb) * (float)d); sc[r] *= (d == 0 ? 2.f : e); }
#pragma unroll
            for (int s2 = 0; s2 < 2; ++s2) { u32x4 w; w.x = cvtpk(sc[8 * s2], sc[8 * s2 + 1]); w.y = cvtpk(sc[8 * s2 + 2], sc[8 * s2 + 3]); w.z = cvtpk(sc[8 * s2 + 4], sc[8 * s2 + 5]); w.w = cvtpk(sc[8 * s2 + 6], sc[8 * s2 + 7]);
                const bf16x8 pf = __builtin_bit_cast(bf16x8, w);
#pragma unroll
                for (int nb = 0; nb < 2; ++nb) { const bf16x8 vf = trfrag_acc(Vt + nb * 8192 + (32 * kb + 16 * s2 + 4 * hi) * 64 + troff);
                    oi[nb] = __builtin_amdgcn_mfma_f32_32x32x16_bf16(pf, vf, oi[nb], 0, 0, 0); } }
        }
#pragma unroll
        for (int nb = 0; nb < 2; ++nb)
#pragma unroll
            for (int s2 = 0; s2 < 4; ++s2) { const int ro = nb * 4096 + (16 * s2 + 8 * hi) * 64 + troff;
                of[nb] = __builtin_amdgcn_mfma_f32_32x32x16_bf16(qf[s2], trfrag_nat(Sf + ro), of[nb], 0, 0, 0);
                ob[nb] = __builtin_amdgcn_mfma_f32_32x32x16_bf16(qf[s2], trfrag_nat(Sbk + ro), ob[nb], 0, 0, 0); }
        LAS float* stg = (LAS float*)(L + 65536 + wave * 8704);
#pragma unroll
        for (int r = 0; r < 16; ++r) { const int n = 32 * wq + crow(r, hi); const float sf = __builtin_amdgcn_exp2f(lgf * (float)(n + 1)), sb = __builtin_amdgcn_exp2f(lgb * (float)(128 - n));
            stg[crow(r, hi) * 68 + r32] = oi[0][r] + sf * of[0][r] + sb * ob[0][r]; stg[crow(r, hi) * 68 + 32 + r32] = oi[1][r] + sf * of[1][r] + sb * ob[1][r]; }
        asm volatile("s_waitcnt lgkmcnt(0)" ::: "memory");
        { float v[32]; float sm = 0.f;
#pragma unroll
          for (int c4 = 0; c4 < 8; ++c4) { const f32x4 t = *(const LAS f32x4*)(stg + r32 * 68 + 32 * hi + 4 * c4); v[4 * c4] = t[0]; v[4 * c4 + 1] = t[1]; v[4 * c4 + 2] = t[2]; v[4 * c4 + 3] = t[3]; sm += (t[0] + t[1]) + (t[2] + t[3]); }
          const float mu = swapsum(sm) * (1.f / 64.f); float vs = 0.f;
#pragma unroll
          for (int i = 0; i < 32; ++i) { v[i] -= mu; vs += v[i] * v[i]; }
          const float rs = rsqrtf(swapsum(vs) * (1.f / 64.f) + 1e-5f);
          const size_t row = row0 + 32 * wq + r32; const bf16_t* gp = QKV + row * ABIN + 1536 + h * 64 + 32 * hi; const LAS float* gn = gnl + 32 * hi; bf16_t* op = MIX + row * D + h * 64 + 32 * hi;
          u32x4 gw4[4];
#pragma unroll
          for (int c8 = 0; c8 < 4; ++c8) gw4[c8] = __builtin_nontemporal_load((const u32x4*)(gp + 8 * c8));
#pragma unroll
          for (int c8 = 0; c8 < 4; ++c8) { float g[8], t[8]; unpack8(gw4[c8], g);
#pragma unroll
              for (int i = 0; i < 8; ++i) t[i] = v[8 * c8 + i] * rs * gn[8 * c8 + i] * g[i] * __builtin_amdgcn_rcpf(1.f + __builtin_amdgcn_exp2f(-LOG2E * g[i]));
              store8_bf16(op + 8 * c8, t); } }
        asm volatile("s_waitcnt lgkmcnt(0)" ::: "memory"); __syncthreads();
    }
}
__device__ __forceinline__ void phase_ret(Ctx& F) {
    if (F.blk < 128) ret_unit(F, F.blk);
    __syncthreads();
}

#define XB_TMO      128
#define XB_XCNT(j)  (256  + 64 * (j))
#define XB_XSUB(j)  (1280 + 64 * (j))
#define XB_XGEN(j)  (2304 + 64 * (j))
#define XB_TOP      3328
#define XB_TOPGEN   3392
#define XCD_BAR_WORDS 3456
#define XB_SPIN_CAP (1u << 18)

__device__ __forceinline__ unsigned xb_ld(unsigned* p)              { return __hip_atomic_load(p, __ATOMIC_RELAXED, __HIP_MEMORY_SCOPE_AGENT); }
__device__ __forceinline__ unsigned xb_add(unsigned* p, unsigned v) { return __hip_atomic_fetch_add(p, v, __ATOMIC_RELAXED, __HIP_MEMORY_SCOPE_AGENT); }
__device__ __forceinline__ unsigned xb_xcc_id() { return (unsigned)__builtin_amdgcn_s_getreg((3 << 11) | 20) & 0xFu; }
#define XB_SPIN(cond, bar) do { unsigned _sp = 0; while (cond) { __builtin_amdgcn_s_sleep(1); \
    if ((++_sp & 255u) == 0u) { if (xb_ld(&(bar)[XB_TMO])) break; if (_sp > XB_SPIN_CAP) { atomicAdd(&(bar)[XB_TMO], 1u); break; } } } } while (0)

struct XcdBarrier {
    unsigned* bar; unsigned x;
    volatile LAS unsigned* st;
};

__device__ __forceinline__ XcdBarrier xcd_barrier_post(unsigned* bar, volatile LAS unsigned* st) {
    XcdBarrier b; b.bar = bar; b.x = xb_xcc_id(); b.st = st;
    if (threadIdx.x == 0) (void)xb_add(&bar[XB_XCNT(b.x)], 1u);
    return b;
}
__device__ __forceinline__ void xcd_barrier_complete(unsigned* bar, unsigned x, unsigned& nloc, unsigned& nx) {
    const unsigned G = gridDim.x * gridDim.y * gridDim.z;
    unsigned sum, cnt, mine, sp = 0u;
    for (;;) {
        sum = 0u; cnt = 0u; mine = 0u;
#pragma unroll
        for (unsigned j = 0; j < 16; ++j) { const unsigned c = xb_ld(&bar[XB_XCNT(j)]); sum += c; cnt += (c > 0u) ? 1u : 0u; mine = (j == x) ? c : mine; }
        if (sum == G) break;
        __builtin_amdgcn_s_sleep(1);
        if ((++sp & 255u) == 0u) { if (xb_ld(&bar[XB_TMO])) break; if (sp > XB_SPIN_CAP) { atomicAdd(&bar[XB_TMO], 1u); break; } }
    }
    nloc = mine > 0u ? mine : 1u; nx = cnt > 0u ? cnt : 1u;
}

__device__ __forceinline__ void xcd_barrier(const XcdBarrier& b, const bool leader) {
    asm volatile("s_waitcnt vmcnt(0)" ::: "memory");
    __syncthreads();
    if (leader) {
        unsigned* bar = b.bar;
        __builtin_amdgcn_s_waitcnt(0);
        unsigned nloc = b.st[0], nx = b.st[1];
        if (nloc == 0u) { xcd_barrier_complete(bar, b.x, nloc, nx); b.st[0] = nloc; b.st[1] = nx; }
        const unsigned old = xb_add(&bar[XB_XSUB(b.x)], 1u);
        const unsigned gen = old / nloc;
        if (old + 1u == (gen + 1u) * nloc) {
            __builtin_amdgcn_fence(__ATOMIC_RELEASE, "agent");
            asm volatile("s_waitcnt vmcnt(0)" ::: "memory");
            const unsigned og = xb_add(&bar[XB_TOP], 1u);
            const unsigned tg = og / nx;
            if (og + 1u == (tg + 1u) * nx) xb_add(&bar[XB_TOPGEN], 1u);
            else XB_SPIN(xb_ld(&bar[XB_TOPGEN]) == tg, bar);
            __builtin_amdgcn_fence(__ATOMIC_ACQUIRE, "agent");
            xb_add(&bar[XB_XGEN(b.x)], 1u);
            asm volatile("s_waitcnt vmcnt(0)" ::: "memory");
        } else {
            XB_SPIN(xb_ld(&bar[XB_XGEN(b.x)]) == gen, bar);
            __builtin_amdgcn_fence(__ATOMIC_ACQUIRE, "agent");
            asm volatile("s_waitcnt vmcnt(0)" ::: "memory");
        }
    }
    __syncthreads();
}

constexpr int LDS_BYTES = 150 * 1024;
constexpr int NPHASE = 18;
__global__ void __launch_bounds__(NTHREADS, 2) fwd_kernel(Args args) {
    extern __shared__ __attribute__((aligned(16))) unsigned char lds_raw[];
    Ctx F;
#pragma unroll
    for (int i = 0; i < 22; ++i) F.in[i] = args.in[i];
    F.out = args.out; F.ws = args.ws; F.lds = (LAS unsigned char*)lds_raw;
    F.tid = threadIdx.x; F.lane = F.tid & 63; F.wave = __builtin_amdgcn_readfirstlane(F.tid >> 6); F.blk = blockIdx.x; F.nblk = gridDim.x;
    const float* mod = (const float*)(F.ws + WS_MOD); const float* rt = (const float*)(F.ws + WS_ROPE);
    const int* tile_e = (const int*)(F.ws + WS_ROUTE + RT_TILEE);
    cg::grid_group grid = cg::this_grid();
    const int lo = args.ph_lo, hi = args.ph_hi;
    volatile LAS unsigned* bst = (volatile LAS unsigned*)(F.lds + LDS_BYTES - 16);
    if (F.tid < 4) bst[F.tid] = 0u;
    __syncthreads();
    XcdBarrier bar = xcd_barrier_post((unsigned*)(F.ws + WS_CTL) + 1024, bst);
    if (hi > NPHASE) grid.sync();
#ifndef REPEAT_MASK
#define REPEAT_MASK 0
#endif
#define PH(k) asm volatile("v_mbcnt_lo_u32_b32 %0, -1, 0\n\tv_mbcnt_hi_u32_b32 %0, -1, %0" : "=v"(F.lane)); F.tid = F.wave * 64 + F.lane; if (lo <= (k) && (k) < hi)
#define SEAM(k) do { if ((k) + 1 < hi) xcd_barrier(bar, F.tid == 0); } while (0)
    PH(0) { phase_prep(F); }
    PH(1) { wait_mod(F); phase_cvec(F); phase_norm0(F); SEAM(1); }
    PH(2) { { GemmDesc g{(const bf16_t*)(F.ws + WS_H), D, (const bf16_t*)(F.ws + WS_WIN0), D, NTOK / 256, ABIN / 256, nullptr, 0};
                  gemm_run(F, g, EpiIn0{(bf16_t*)(F.ws + WS_QKV), rt}); } SEAM(2); }
    PH(3) { phase_ret(F); asm volatile("v_mbcnt_lo_u32_b32 %0, -1, 0\n\tv_mbcnt_hi_u32_b32 %0, -1, %0" : "=v"(F.lane)); F.tid = F.wave * 64 + F.lane; phase_na(F); SEAM(3); }
    PH(4) { { GemmDesc g{(const bf16_t*)(F.ws + WS_MIX), D, (const bf16_t*)(F.ws + WS_WOUT0), D, NTOK / 256, 4, nullptr, 0};
                  const int pre = ((F.blk & 7) * 5) >> 3;
                  conv_tail(F, 64, 0, 0, pre); __syncthreads();
                  gemm_run(F, g, EpiRes{F.in[I_X], F.in[I_CTX], (bf16_t*)(F.ws + WS_XB), mod});  conv_tail(F, 64, 0, pre, 4); } SEAM(4); }
    PH(5) { phase_router(F, 0, NTOK); SEAM(5); }
    PH(6) { phase_slots(F, 0, NTOK); SEAM(6); }
    PH(7) { { GemmDesc g{(const bf16_t*)(F.ws + WS_H), D, (const bf16_t*)(F.ws + WS_WGU), D, tile_e[320], 4, tile_e, (size_t)1024 * 1024, (const int*)(F.ws + WS_STOK)};
                  gemm_run(F, g, EpiGU{(bf16_t*)(F.ws + WS_ACT)}); } SEAM(7); }
    PH(8) { { GemmDesc g{(const bf16_t*)(F.ws + WS_ACT), FF, (const bf16_t*)(F.ws + WS_WDN), FF, tile_e[320], 4, tile_e, (size_t)1024 * 512};
                  gemm_run(F, g, EpiY{(bf16_t*)(F.ws + WS_Y)}); } SEAM(8); }
    PH(9) { phase_combine(F, 0); SEAM(9); }
    PH(10) { { GemmDesc g{(const bf16_t*)(F.ws + WS_H), D, (const bf16_t*)(F.ws + WS_WIN1), D, NL / 256, 6, nullptr, 0};
                   gemm_run(F, g, EpiIn1{(bf16_t*)(F.ws + WS_QKV), rt, 0, 0});
                   GemmDesc g2{(const bf16_t*)(F.ws + WS_H) + (size_t)NL * D, D, (const bf16_t*)(F.ws + WS_WIN1) + (size_t)1024 * D, D, NC / 256, 2, nullptr, 0};
                   gemm_run(F, g2, EpiIn1{(bf16_t*)(F.ws + WS_QKV), rt, 1024, NL});  conv_tail(F, 32, 6144, 0, 4); } SEAM(10); }
    PH(11) { phase_swa(F); SEAM(11); }
    PH(12) { { GemmDesc g{(const bf16_t*)(F.ws + WS_MIX), D, (const bf16_t*)(F.ws + WS_WOUT1), D, NL / 256, 4, nullptr, 0};
                   gemm_run(F, g, EpiRes{nullptr, nullptr, (bf16_t*)(F.ws + WS_XB), mod + 17 * 6144}); } SEAM(12); }
    PH(13) { phase_router(F, 1, NL); SEAM(13); }
    PH(14) { phase_slots(F, 1, NL); SEAM(14); }
    PH(15) { { GemmDesc g{(const bf16_t*)(F.ws + WS_H), D, (const bf16_t*)(F.ws + WS_WGU) + (size_t)32 * 1024 * 1024, D, tile_e[320], 4, tile_e, (size_t)1024 * 1024, (const int*)(F.ws + WS_STOK)};
                   gemm_run(F, g, EpiGU{(bf16_t*)(F.ws + WS_ACT)}); } SEAM(15); }
    PH(16) { { GemmDesc g{(const bf16_t*)(F.ws + WS_ACT), FF, (const bf16_t*)(F.ws + WS_WDN) + (size_t)32 * 1024 * 512, FF, tile_e[320], 4, tile_e, (size_t)1024 * 512};
                   gemm_run(F, g, EpiY{(bf16_t*)(F.ws + WS_Y)}); } SEAM(16); }
    PH(17) { phase_combine(F, 1); SEAM(17); }
#undef PH
#undef SEAM
}

extern "C" void kernel_launch(void* const* d_in, const int* in_sizes, int n_in, void* d_out, int out_size, void* d_ws, size_t ws_size, hipStream_t stream) {
    static int ready = 0, grid_blocks = 0;
    if (!ready) {
        if (n_in != 22 || out_size != NL * D || ws_size < WS_END) { fprintf(stderr, "kernel_launch: unexpected shapes (n_in %d out %d ws %zu)\n", n_in, out_size, ws_size); ready = -1; return; }
        if (hipFuncSetAttribute((const void*)fwd_kernel, hipFuncAttributeMaxDynamicSharedMemorySize, LDS_BYTES) != hipSuccess) { fprintf(stderr, "kernel_launch: hipFuncSetAttribute failed\n"); ready = -1; return; }
        int dev = 0, cus = 0, per_cu = 0;
        (void)hipGetDevice(&dev); (void)hipDeviceGetAttribute(&cus, hipDeviceAttributeMultiprocessorCount, dev);
        if (hipOccupancyMaxActiveBlocksPerMultiprocessor(&per_cu, (const void*)fwd_kernel, NTHREADS, LDS_BYTES) != hipSuccess || per_cu < 1) { fprintf(stderr, "kernel_launch: occupancy query failed (%d)\n", per_cu); ready = -1; return; }
        if (cus * per_cu < 256) { fprintf(stderr, "kernel_launch: needs 256 co-resident workgroups, device admits %d x %d\n", cus, per_cu); ready = -1; return; }
        grid_blocks = 256;
        ready = 1;
    }
    if (ready < 0) return;
    Args a{};
    for (int i = 0; i < 22; ++i) a.in[i] = (const float*)d_in[i];
    a.out = (float*)d_out; a.ws = (unsigned char*)d_ws;
    a.ph_lo = 0; a.ph_hi = NPHASE;
    if (hipMemsetAsync((char*)d_ws + WS_CTL, 0, 65536, stream) != hipSuccess) { fprintf(stderr, "kernel_launch: memset failed\n"); return; }
    void* kargs[] = {&a};
    hipError_t e = hipLaunchCooperativeKernel((const void*)fwd_kernel, dim3(grid_blocks), dim3(NTHREADS), kargs, LDS_BYTES, stream);
    if (e != hipSuccess) fprintf(stderr, "cooperative launch failed: %s (grid %d)\n", hipGetErrorString(e), grid_blocks);
}
```

```cpp
#include <hip/hip_runtime.h>
#include <hip/hip_cooperative_groups.h>
namespace cg = cooperative_groups;
#include <cstdio>
#include <cstdint>

#define LAS __attribute__((address_space(3)))
typedef unsigned short bf16_t;
typedef float f32x4 __attribute__((ext_vector_type(4)));
typedef unsigned u32x4 __attribute__((ext_vector_type(4)));
typedef unsigned u32x2 __attribute__((ext_vector_type(2)));
typedef short bf16x8 __attribute__((ext_vector_type(8)));

constexpr int D = 1024, NB = 16, SEQ = 2048, CTXL = 256, GW = 64;
constexpr int NL = NB * SEQ, NC = NB * CTXL, NTOK = NL + NC;
constexpr int ABIN = 3584, SWAIN = 1536, FF = 512, NEXP = 32;
constexpr int NTHREADS = 512, NWAVES = 8;
constexpr int MAXSLOT = 81920;
constexpr float LOG2E = 1.4426950408889634f;

constexpr size_t MiB = 1u << 20;
constexpr size_t WS_CTL = 0;
constexpr size_t WS_MOD = 1 * MiB;
constexpr size_t WS_ROPE = 2 * MiB;
constexpr size_t WS_RW = 2 * MiB + 16384;
constexpr size_t WS_ROUTE = 2 * MiB + 16384 + 393216;
constexpr size_t WS_WIN0 = 4 * MiB;
constexpr size_t WS_WOUT0 = 12 * MiB;
constexpr size_t WS_WIN1 = 14 * MiB;
constexpr size_t WS_WOUT1 = 18 * MiB;
constexpr size_t WS_WGU = 20 * MiB;
constexpr size_t WS_WDN = 148 * MiB;
constexpr size_t WS_STOK = 212 * MiB;
constexpr size_t WS_XC = 212 * MiB;
constexpr size_t WS_H = 228 * MiB;
constexpr size_t WS_MIX = 300 * MiB;
constexpr size_t WS_QKV = 372 * MiB;
constexpr size_t WS_HS = WS_QKV;
constexpr size_t WS_ACT = WS_QKV + 160 * MiB;
constexpr size_t WS_Y = 624 * MiB;
constexpr size_t WS_XB = 784 * MiB;
constexpr size_t WS_END = 856 * MiB;
constexpr size_t RT_TOKE = 0;
constexpr size_t RT_TOKW = RT_TOKE + (size_t)NTOK * 8;
constexpr size_t RT_TOKR = RT_TOKW + (size_t)NTOK * 8;
constexpr size_t RT_TOKS = RT_TOKR + (size_t)NTOK * 8;
constexpr size_t RT_BCNT = RT_TOKS + (size_t)NTOK * 8;
constexpr size_t RT_TILEE = RT_BCNT + 256 * 32 * 4;
constexpr size_t RT_CVEC = RT_TILEE + 324 * 4 + 16;
constexpr size_t RT_RSTD = RT_CVEC + 2 * 17 * 48 * 4;
constexpr size_t RT_END = RT_RSTD + (size_t)NTOK * 4;
static_assert(WS_ROUTE + RT_END <= WS_WIN0, "route arrays");

__device__ __forceinline__ float bf2f(unsigned v) { return __uint_as_float(v << 16); }
__device__ __forceinline__ unsigned f2bf(float f) { unsigned u = __float_as_uint(f); return (u + 0x7fffu + ((u >> 16) & 1u)) >> 16; }
__device__ __forceinline__ unsigned pk2(float lo, float hi) { typedef float f2_t __attribute__((ext_vector_type(2))); typedef __bf16 b2_t __attribute__((ext_vector_type(2)));
    f2_t v = {lo, hi}; b2_t b = __builtin_convertvector(v, b2_t); return __builtin_bit_cast(unsigned, b); }
__device__ __forceinline__ void store8_bf16(bf16_t* p, const float* v) { u32x4 w; w.x = pk2(v[0], v[1]); w.y = pk2(v[2], v[3]); w.z = pk2(v[4], v[5]); w.w = pk2(v[6], v[7]); *(u32x4*)p = w; }
__device__ __forceinline__ float wave_sum(float v) {
#pragma unroll
    for (int o = 1; o < 64; o <<= 1) v += __shfl_xor(v, o);
    return v;
}
__device__ __forceinline__ float silu_f(float v) { return v / (1.f + __expf(-v)); }
__device__ __forceinline__ void unpack8(const u32x4 w, float* f) {
    f[0] = bf2f(w.x & 0xffffu); f[1] = bf2f(w.x >> 16); f[2] = bf2f(w.y & 0xffffu); f[3] = bf2f(w.y >> 16);
    f[4] = bf2f(w.z & 0xffffu); f[5] = bf2f(w.z >> 16); f[6] = bf2f(w.w & 0xffffu); f[7] = bf2f(w.w >> 16);
}

struct Args { const float* in[22]; float* out; unsigned char* ws; int ph_lo, ph_hi; };
enum { I_X = 0, I_C, I_CTX, I_CCTX, I_ADAW, I_ADAB, I_NORMG, I_FINALG, I_ABWIN, I_ABWOUT, I_RETDEC, I_RETGN, I_RPB, I_SWAWIN, I_SWAWOUT, I_SINK,
       I_RGW, I_RGB, I_REW, I_REB, I_WGU, I_WDN };

struct Ctx {
    const float* in[22]; float* out; unsigned char* ws;
    LAS unsigned char* lds;
    int tid, lane, wave, blk, nblk;
};

template <class DMap>
__device__ __forceinline__ void transpose_item(const float* W, int K, int N, bf16_t* WT, int k0, int n0, const DMap& dmap, LAS float* scr, int lane) {
    const int c4 = lane & 15, kr = lane >> 4;
#pragma unroll
    for (int i = 0; i < 16; ++i) { const int kk = 4 * i + kr; *(LAS f32x4*)(scr + kk * 68 + 4 * c4) = __builtin_nontemporal_load((const f32x4*)(W + (size_t)(k0 + kk) * N + n0 + 4 * c4)); }
    asm volatile("s_waitcnt lgkmcnt(0)" ::: "memory");
    const int c = lane & 7;
#pragma unroll
    for (int j = 0; j < 8; ++j) { const int n = (lane >> 3) + 8 * j; const LAS float* sp = scr + (8 * c) * 68 + n;
        u32x4 o; o.x = pk2(sp[0 * 68], sp[1 * 68]); o.y = pk2(sp[2 * 68], sp[3 * 68]); o.z = pk2(sp[4 * 68], sp[5 * 68]); o.w = pk2(sp[6 * 68], sp[7 * 68]);
        __builtin_nontemporal_store(o, (u32x4*)(WT + (size_t)dmap(n0 + n) * K + k0 + 8 * c)); }
    asm volatile("s_waitcnt lgkmcnt(0)" ::: "memory");
}
struct DMapId { __device__ __forceinline__ int operator()(int n) const { return n; } };
__device__ __forceinline__ int gu_row(int n) { const int u = n >= 512, g = n & 511; return 256 * (g >> 7) + 128 * u + (g & 127); }
struct DMapGU { __device__ __forceinline__ int operator()(int n) const { return gu_row(n); } };

__device__ __forceinline__ void phase_prep(Ctx& F) {
    if (F.blk < 192) {
        const int l = F.blk / 96, col0 = (F.blk % 96) * 64;
        LAS float* s = (LAS float*)F.lds;
        LAS float* red = (LAS float*)(F.lds + 17 * 1024 * 4);
        for (int idx = F.tid; idx < 17 * 1024; idx += NTHREADS) { const int r = idx >> 10, k = idx & 1023; const float v = r < 16 ? F.in[I_C][r * 1024 + k] : F.in[I_CCTX][k]; s[idx] = silu_f(v); }
        __syncthreads();
        float acc[17];
#pragma unroll
        for (int r = 0; r < 17; ++r) acc[r] = 0.f;
        const float* wp = F.in[I_ADAW] + ((size_t)l * 1024 + F.wave * 128) * 6144 + col0 + F.lane;
        for (int k0 = 0; k0 < 128; k0 += 16) { float wv[16];
#pragma unroll
            for (int j = 0; j < 16; ++j) wv[j] = __builtin_nontemporal_load(wp + (size_t)(k0 + j) * 6144);
#pragma unroll
            for (int j = 0; j < 16; ++j)
#pragma unroll
                for (int r = 0; r < 17; ++r) acc[r] += s[r * 1024 + F.wave * 128 + k0 + j] * wv[j]; }
#pragma unroll
        for (int r = 0; r < 17; ++r) red[(F.wave * 17 + r) * 64 + F.lane] = acc[r];
        __syncthreads();
        float* mod = (float*)(F.ws + WS_MOD);
        for (int idx = F.tid; idx < 17 * 64; idx += NTHREADS) { const int r = idx >> 6, cl = idx & 63; float v = F.in[I_ADAB][l * 6144 + col0 + cl];
#pragma unroll
            for (int w = 0; w < 8; ++w) v += red[(w * 17 + r) * 64 + cl];
            mod[(size_t)(l * 17 + r) * 6144 + col0 + cl] = v; }
        asm volatile("s_waitcnt vmcnt(0)" ::: "memory");
        __syncthreads();
        if (F.tid == 0) { __builtin_amdgcn_fence(__ATOMIC_RELEASE, "agent"); asm volatile("s_waitcnt vmcnt(0)" ::: "memory");
            __hip_atomic_fetch_add((unsigned*)(F.ws + WS_CTL) + 400, 1u, __ATOMIC_RELAXED, __HIP_MEMORY_SCOPE_AGENT); }
    }
    if (F.blk == F.nblk - 1) {
        float* rt = (float*)(F.ws + WS_ROPE);
        for (int idx = F.tid; idx < 1024; idx += NTHREADS) { const int pos = idx >> 4, f = idx & 15;
            const float inv = exp2f(-(float)f * (13.287712379549449f / 16.f));
            const float ang = (float)pos * inv; const double rev = (double)ang * 0.15915494309189535; const float fr = (float)(rev - floor(rev));
            rt[idx * 2] = __builtin_amdgcn_cosf(fr); rt[idx * 2 + 1] = __builtin_amdgcn_sinf(fr); }
    }
    if (F.blk == F.nblk - 2) {
        bf16_t* rw = (bf16_t*)(F.ws + WS_RW);
        for (int idx = F.tid; idx < 2 * 48 * 1024; idx += NTHREADS) { const int l = idx / 49152, rem = idx % 49152, c = rem >> 10, k = rem & 1023;
            const float w = c < 4 ? F.in[I_RGW][(size_t)(l * 1024 + k) * 4 + c] : (c < 36 ? F.in[I_REW][(size_t)(l * 1024 + k) * 32 + c - 4] : 0.f);
            const unsigned h = f2bf(w); const float r = w - bf2f(h);
            rw[(size_t)(l * 2) * 49152 + rem] = (bf16_t)h; rw[(size_t)(l * 2 + 1) * 49152 + rem] = (bf16_t)f2bf(r); }
    }
    __syncthreads();
    LAS float* scr = (LAS float*)(F.lds + F.wave * 17408);
    const int gw = F.blk * NWAVES + F.wave, NGW = F.nblk * NWAVES;
    constexpr int I0 = 16 * 56, I1 = 16 * 16, I2 = 16 * 24, I3 = 16 * 16, I4 = 32 * 16 * 16, I5 = 32 * 8 * 16;
    unsigned* q = (unsigned*)(F.ws + WS_CTL) + 208; LAS unsigned* qb = (LAS unsigned*)(F.lds + 139264 + 64);
    for (;;) {
        __syncthreads();
        if (F.tid == 0) *qb = atomicAdd(q, 8u);
        __syncthreads();
        const unsigned base = *qb; if (base >= (unsigned)(I0 + I1 + I2 + I3 + I4 + I5)) break;
        int r = (int)base + F.wave; if (r >= I0 + I1 + I2 + I3 + I4 + I5) continue;
        if (r < I0) { transpose_item(F.in[I_ABWIN], 1024, ABIN, (bf16_t*)(F.ws + WS_WIN0), 64 * (r / 56), 64 * (r % 56), DMapId{}, scr, F.lane); continue; } r -= I0;
        if (r < I1) { transpose_item(F.in[I_ABWOUT], 1024, 1024, (bf16_t*)(F.ws + WS_WOUT0), 64 * (r / 16), 64 * (r % 16), DMapId{}, scr, F.lane); continue; } r -= I1;
        if (r < I2) { transpose_item(F.in[I_SWAWIN], 1024, SWAIN, (bf16_t*)(F.ws + WS_WIN1), 64 * (r / 24), 64 * (r % 24), DMapId{}, scr, F.lane); continue; } r -= I2;
        if (r < I3) { transpose_item(F.in[I_SWAWOUT], 1024, 1024, (bf16_t*)(F.ws + WS_WOUT1), 64 * (r / 16), 64 * (r % 16), DMapId{}, scr, F.lane); continue; } r -= I3;
        if (r < I4) { const int e = r / 256, q2 = r % 256;
            transpose_item(F.in[I_WGU] + (size_t)e * 1024 * 1024, 1024, 1024, (bf16_t*)(F.ws + WS_WGU) + (size_t)e * 1024 * 1024, 64 * (q2 / 16), 64 * (q2 % 16), DMapGU{}, scr, F.lane); continue; } r -= I4;
        { const int e = r / 128, q2 = r % 128;
            transpose_item(F.in[I_WDN] + (size_t)e * 512 * 1024, 512, 1024, (bf16_t*)(F.ws + WS_WDN) + (size_t)e * 1024 * 512, 64 * (q2 / 16), 64 * (q2 % 16), DMapId{}, scr, F.lane); }
    }
}
__device__ __forceinline__ void conv_tail(Ctx& F, int first, int item0) {
    __syncthreads();
    if (F.blk < first) return;
    LAS float* scr = (LAS float*)(F.lds + F.wave * 17408);
    const int wi = (F.blk - first) * NWAVES + F.wave;
    for (int j = 0; j < 4; ++j) { const int it = item0 + wi * 4 + j; if (it >= 12288) break;
        if (it < 8192) { const int e = 32 + it / 256, q = it % 256;
            transpose_item(F.in[I_WGU] + (size_t)e * 1024 * 1024, 1024, 1024, (bf16_t*)(F.ws + WS_WGU) + (size_t)e * 1024 * 1024, 64 * (q / 16), 64 * (q % 16), DMapGU{}, scr, F.lane); }
        else { const int r = it - 8192, e = 32 + r / 128, q = r % 128;
            transpose_item(F.in[I_WDN] + (size_t)e * 512 * 1024, 512, 1024, (bf16_t*)(F.ws + WS_WDN) + (size_t)e * 1024 * 512, 64 * (q / 16), 64 * (q % 16), DMapId{}, scr, F.lane); } }
}

struct RowMod { float a[16], s[16]; };
__device__ __forceinline__ void load_rowmod(const Ctx& F, int l, int which, int b, RowMod& M) {
    const float* mod = (const float*)(F.ws + WS_MOD) + (size_t)(l * 17 + b) * 6144;
    const float* g = F.in[I_NORMG] + (size_t)(l * 2 + which) * 1024;
#pragma unroll
    for (int j = 0; j < 4; ++j) { const int c = 4 * F.lane + 256 * j;
        const f32x4 gv = *(const f32x4*)(g + c), sh = *(const f32x4*)(mod + which * 3072 + c), sc = *(const f32x4*)(mod + which * 3072 + 1024 + c);
#pragma unroll
        for (int i = 0; i < 4; ++i) { M.a[4 * j + i] = gv[i] * (1.f + sc[i]); M.s[4 * j + i] = sh[i]; } }
}
__device__ __forceinline__ void load_row16(const float* p, int lane, float* v) {
#pragma unroll
    for (int j = 0; j < 4; ++j) { const f32x4 t = __builtin_nontemporal_load((const f32x4*)(p + 4 * lane + 256 * j)); v[4 * j] = t[0]; v[4 * j + 1] = t[1]; v[4 * j + 2] = t[2]; v[4 * j + 3] = t[3]; }
}
__device__ __forceinline__ void load_row16_bf16(const bf16_t* p, int lane, float* v) {
#pragma unroll
    for (int j = 0; j < 4; ++j) { const u32x2 w = *(const u32x2*)(p + 4 * lane + 256 * j); v[4 * j] = bf2f(w.x & 0xffffu); v[4 * j + 1] = bf2f(w.x >> 16); v[4 * j + 2] = bf2f(w.y & 0xffffu); v[4 * j + 3] = bf2f(w.y >> 16); }
}
__device__ __forceinline__ void load_row16_bf16_nt(const bf16_t* p, int lane, float* v) {
#pragma unroll
    for (int j = 0; j < 4; ++j) { const u32x2 w = __builtin_nontemporal_load((const u32x2*)(p + 4 * lane + 256 * j)); v[4 * j] = bf2f(w.x & 0xffffu); v[4 * j + 1] = bf2f(w.x >> 16); v[4 * j + 2] = bf2f(w.y & 0xffffu); v[4 * j + 3] = bf2f(w.y >> 16); }
}
__device__ __forceinline__ void store_row16_bf16(bf16_t* p, int lane, const float* v) {
#pragma unroll
    for (int j = 0; j < 4; ++j) { u32x2 w; w.x = pk2(v[4 * j], v[4 * j + 1]); w.y = pk2(v[4 * j + 2], v[4 * j + 3]); *(u32x2*)(p + 4 * lane + 256 * j) = w; }
}
__device__ __forceinline__ void store_row16_f32(float* p, int lane, const float* v) {
#pragma unroll
    for (int j = 0; j < 4; ++j) { f32x4 t = {v[4 * j], v[4 * j + 1], v[4 * j + 2], v[4 * j + 3]}; *(f32x4*)(p + 4 * lane + 256 * j) = t; }
}
__device__ __forceinline__ void store_row16_f32_nt(float* p, int lane, const float* v) {
#pragma unroll
    for (int j = 0; j < 4; ++j) { f32x4 t = {v[4 * j], v[4 * j + 1], v[4 * j + 2], v[4 * j + 3]}; __builtin_nontemporal_store(t, (f32x4*)(p + 4 * lane + 256 * j)); }
}
__device__ __forceinline__ float row_rstd(const float* v) {
    float ss = 0.f;
#pragma unroll
    for (int i = 0; i < 16; ++i) ss += v[i] * v[i];
    return rsqrtf(wave_sum(ss) * (1.f / 1024.f) + 1e-6f);
}

__device__ __forceinline__ const float* xrow_in(const Ctx& F, int row) { return row < NL ? F.in[I_X] + (size_t)row * D : F.in[I_CTX] + (size_t)(row - NL) * D; }
__device__ __forceinline__ bf16_t* xrow_cur(const Ctx& F, int row) { return (bf16_t*)(F.ws + WS_XB) + (size_t)row * D; }
__device__ __forceinline__ void wait_mod(Ctx& F) {
    if (F.tid == 0) { unsigned* flag = (unsigned*)(F.ws + WS_CTL) + 400; unsigned spins = 0;
        while (__hip_atomic_load(flag, __ATOMIC_RELAXED, __HIP_MEMORY_SCOPE_AGENT) < 192u) { __builtin_amdgcn_s_sleep(4); if (++spins > (1u << 22)) break; }
        __builtin_amdgcn_fence(__ATOMIC_ACQUIRE, "agent"); asm volatile("s_waitcnt vmcnt(0)" ::: "memory"); }
    __syncthreads();
}
__device__ __forceinline__ void phase_norm0(Ctx& F) {
    bf16_t* H = (bf16_t*)(F.ws + WS_H);
    const int r0 = (F.blk * NWAVES + F.wave) * 18, r1 = r0 + 18 < NTOK ? r0 + 18 : NTOK; int curb = -1; RowMod M;
    float nx[16]; if (r0 < r1) load_row16(xrow_in(F, r0), F.lane, nx);
    for (int row = r0; row < r1; ++row) {
        float v[16];
#pragma unroll
        for (int i = 0; i < 16; ++i) v[i] = nx[i];
        load_row16(xrow_in(F, row + 1 < r1 ? row + 1 : row), F.lane, nx);
        const int b = row < NL ? row >> 11 : 16;
        if (b != curb) { load_rowmod(F, 0, 0, b, M); curb = b; }
        const float rstd = row_rstd(v);
#pragma unroll
        for (int i = 0; i < 16; ++i) v[i] = v[i] * rstd * M.a[i] + M.s[i];
        store_row16_bf16(H + (size_t)row * D, F.lane, v);
    }
}

__device__ __forceinline__ void phase_cvec(Ctx& F) {
    if (F.blk >= 34) return;
    const int l = F.blk / 17, b = F.blk % 17;
    const float* sh = (const float*)(F.ws + WS_MOD) + (size_t)(l * 17 + b) * 6144 + 3072;
    LAS float* red = (LAS float*)F.lds;
    const int kg = F.tid >> 5, c = F.tid & 31;
    float acc = 0.f, accg = 0.f;
    for (int k = kg * 64; k < kg * 64 + 64; ++k) { const float sv = sh[k]; acc += sv * F.in[I_REW][(size_t)(l * 1024 + k) * 32 + c]; if (c < 4) accg += sv * F.in[I_RGW][(size_t)(l * 1024 + k) * 4 + c]; }
    red[kg * 36 + 4 + c] = acc; if (c < 4) red[kg * 36 + c] = accg;
    __syncthreads();
    if (F.tid < 36) { float v = F.tid < 4 ? F.in[I_RGB][l * 4 + F.tid] : F.in[I_REB][l * 32 + F.tid - 4];
#pragma unroll
        for (int g = 0; g < 16; ++g) v += red[g * 36 + F.tid];
        ((float*)(F.ws + WS_ROUTE + RT_CVEC))[(l * 17 + b) * 48 + F.tid] = v; }
    __syncthreads();
}
typedef float f32x4v __attribute__((ext_vector_type(4)));
__device__ __forceinline__ void phase_router(Ctx& F, int l, int nrows) {
    LAS float* av = (LAS float*)F.lds;
    LAS float* sv = av + 2048;
    LAS float* cv = sv + 2048;
    LAS int* cnt = (LAS int*)(cv + 96);
    LAS float* part = (LAS float*)(cnt + 32);
    const int row_lo = F.blk * 144; const int row_hi = row_lo + 144 < nrows ? row_lo + 144 : nrows;
    if (F.tid < 32) cnt[F.tid] = 0;
    if (row_lo < nrows) {
        const int b0 = row_lo < NL ? row_lo >> 11 : 16, b1 = (row_hi - 1) < NL ? (row_hi - 1) >> 11 : 16;
        const float* g = F.in[I_NORMG] + (size_t)(l * 2 + 1) * 1024;
        for (int idx = F.tid; idx < 2048; idx += NTHREADS) { const int w = idx >> 10, k = idx & 1023; const float* mod = (const float*)(F.ws + WS_MOD) + (size_t)(l * 17 + (w ? b1 : b0)) * 6144;
            av[idx] = g[k] * (1.f + mod[4096 + k]); sv[idx] = mod[3072 + k]; }
        if (F.tid < 96) { const int w = F.tid / 48, c = F.tid % 48; cv[F.tid] = c < 36 ? ((const float*)(F.ws + WS_ROUTE + RT_CVEC))[(l * 17 + (w ? b1 : b0)) * 48 + c] : 0.f; }
        int* tok_e = (int*)(F.ws + WS_ROUTE + RT_TOKE); float* tok_w = (float*)(F.ws + WS_ROUTE + RT_TOKW); int* tok_r = (int*)(F.ws + WS_ROUTE + RT_TOKR); float* rstd_o = (float*)(F.ws + WS_ROUTE + RT_RSTD);
        const bf16_t* whi = (const bf16_t*)(F.ws + WS_RW) + (size_t)(l * 2) * 49152; const bf16_t* wlo = whi + 49152;
        const int n = F.lane & 15, kq = F.lane >> 4, kw = 128 * F.wave + 8 * kq;
        bf16x8 Wh[4][3], Wl[4][3];
#pragma unroll
        for (int i = 0; i < 4; ++i)
#pragma unroll
            for (int cb = 0; cb < 3; ++cb) { Wh[i][cb] = *(const bf16x8*)(whi + (size_t)(cb * 16 + n) * 1024 + kw + 32 * i); Wl[i][cb] = *(const bf16x8*)(wlo + (size_t)(cb * 16 + n) * 1024 + kw + 32 * i); }
        const int ntask = (row_hi - row_lo) >> 4;
        u32x4 xq[4], xn[4];
#pragma unroll
        for (int i = 0; i < 4; ++i) xq[i] = *(const u32x4*)(xrow_cur(F, row_lo + n) + kw + 32 * i);
        __syncthreads();
        for (int task = 0; task < ntask; ++task) {
            const int r0 = row_lo + 16 * task; const int b = r0 < NL ? r0 >> 11 : 16; const int w = (b == b0) ? 0 : 1;
            { const int rn = task + 1 < ntask ? r0 + 16 : r0;
#pragma unroll
              for (int i = 0; i < 4; ++i) xn[i] = *(const u32x4*)(xrow_cur(F, rn + n) + kw + 32 * i); }
            f32x4v acc[3]; acc[0] = f32x4v{0.f, 0.f, 0.f, 0.f}; acc[1] = acc[0]; acc[2] = acc[0]; float ss = 0.f;
#pragma unroll
            for (int i = 0; i < 4; ++i) { const int k0 = kw + 32 * i;
                float xx[8]; unpack8(xq[i], xx);
                const f32x4 a0 = *(const LAS f32x4*)(av + w * 1024 + k0), a1 = *(const LAS f32x4*)(av + w * 1024 + k0 + 4);
                float xa[8]; unsigned hb[8]; float lo[8];
#pragma unroll
                for (int j = 0; j < 4; ++j) { xa[j] = xx[j] * a0[j]; xa[4 + j] = xx[4 + j] * a1[j]; ss += xx[j] * xx[j] + xx[4 + j] * xx[4 + j]; }
#pragma unroll
                for (int j = 0; j < 8; ++j) { hb[j] = f2bf(xa[j]); lo[j] = xa[j] - bf2f(hb[j]); }
                u32x4 bh, bl; bh.x = hb[0] | (hb[1] << 16); bh.y = hb[2] | (hb[3] << 16); bh.z = hb[4] | (hb[5] << 16); bh.w = hb[6] | (hb[7] << 16);
                bl.x = pk2(lo[0], lo[1]); bl.y = pk2(lo[2], lo[3]); bl.z = pk2(lo[4], lo[5]); bl.w = pk2(lo[6], lo[7]);
                const bf16x8 Bh = __builtin_bit_cast(bf16x8, bh), Bl = __builtin_bit_cast(bf16x8, bl);
#pragma unroll
                for (int cb = 0; cb < 3; ++cb) {
                    acc[cb] = __builtin_amdgcn_mfma_f32_16x16x32_bf16(Wh[i][cb], Bh, acc[cb], 0, 0, 0);
                    acc[cb] = __builtin_amdgcn_mfma_f32_16x16x32_bf16(Wh[i][cb], Bl, acc[cb], 0, 0, 0);
                    acc[cb] = __builtin_amdgcn_mfma_f32_16x16x32_bf16(Wl[i][cb], Bh, acc[cb], 0, 0, 0); }
                __builtin_amdgcn_sched_barrier(0); }
            ss += __shfl_xor(ss, 16); ss += __shfl_xor(ss, 32);
            LAS float* pb = part + ((task & 1) * 8 + F.wave) * 16 * 52 + n * 52;
#pragma unroll
            for (int cb = 0; cb < 3; ++cb) *(LAS f32x4v*)(pb + cb * 16 + 4 * kq) = acc[cb];
            if (kq == 0) pb[48] = ss;
            __syncthreads();
            { const LAS float* pq = part + (task & 1) * 8 * 16 * 52 + n * 52 + 48; float sq = 0.f;
#pragma unroll
              for (int ww = 0; ww < 8; ++ww) sq += pq[ww * 16 * 52];
              const float rstd = rsqrtf(sq * (1.f / 1024.f) + 1e-6f); bf16_t* hp = (bf16_t*)(F.ws + WS_H) + (size_t)(r0 + n) * D;
#pragma unroll
              for (int i = 0; i < 4; ++i) { const int k0 = kw + 32 * i; float xx[8], hh[8]; unpack8(xq[i], xx);
                  const f32x4 a0 = *(const LAS f32x4*)(av + w * 1024 + k0), a1 = *(const LAS f32x4*)(av + w * 1024 + k0 + 4), s0 = *(const LAS f32x4*)(sv + w * 1024 + k0), s1 = *(const LAS f32x4*)(sv + w * 1024 + k0 + 4);
#pragma unroll
                  for (int j = 0; j < 4; ++j) { hh[j] = xx[j] * rstd * a0[j] + s0[j]; hh[4 + j] = xx[4 + j] * rstd * a1[j] + s1[j]; }
                  store8_bf16(hp + k0, hh); } }
            if (F.wave == (task & 7) && F.lane < 16) {
                const int row = r0 + n; const LAS float* p0 = part + (task & 1) * 8 * 16 * 52 + n * 52;
                float lg[36]; float sq = 0.f;
#pragma unroll
                for (int c = 0; c < 36; ++c) lg[c] = 0.f;
#pragma unroll 1
                for (int ww = 0; ww < 8; ++ww) { const LAS float* pp = p0 + ww * 16 * 52;
#pragma unroll
                    for (int c4 = 0; c4 < 9; ++c4) { const f32x4v t = *(const LAS f32x4v*)(pp + 4 * c4); lg[4 * c4] += t[0]; lg[4 * c4 + 1] += t[1]; lg[4 * c4 + 2] += t[2]; lg[4 * c4 + 3] += t[3]; }
                    sq += pp[48]; }
                const float rstd = rsqrtf(sq * (1.f / 1024.f) + 1e-6f);
#pragma unroll
                for (int c = 0; c < 36; ++c) lg[c] = rstd * lg[c] + cv[w * 48 + c];
                int gi = 0; float gm = lg[0]; if (lg[1] > gm) { gm = lg[1]; gi = 1; } if (lg[2] > gm) { gm = lg[2]; gi = 2; } if (lg[3] > gm) { gm = lg[3]; gi = 3; }
                const float gwt = 1.f / (__expf(lg[0] - gm) + __expf(lg[1] - gm) + __expf(lg[2] - gm) + __expf(lg[3] - gm));
                float le[8];
#pragma unroll
                for (int i = 0; i < 8; ++i) { le[i] = lg[4 + i]; if (gi == 1) le[i] = lg[12 + i]; if (gi == 2) le[i] = lg[20 + i]; if (gi == 3) le[i] = lg[28 + i]; }
                int i0 = 0; float v0 = le[0];
#pragma unroll
                for (int i = 1; i < 8; ++i) if (le[i] > v0) { v0 = le[i]; i0 = i; }
                int i1 = -1; float v1 = -3.0e38f;
#pragma unroll
                for (int i = 0; i < 8; ++i) if (i != i0 && le[i] > v1) { v1 = le[i]; i1 = i; }
                const float ex = __expf(v1 - v0), t0 = 1.f / (1.f + ex), t1 = ex * t0;
                const int e0 = gi * 8 + i0, e1 = gi * 8 + i1;
                tok_e[row * 2] = e0; tok_e[row * 2 + 1] = e1; tok_w[row * 2] = gwt * t0; tok_w[row * 2 + 1] = gwt * t1;
                tok_r[row * 2] = atomicAdd((int*)&cnt[e0], 1); tok_r[row * 2 + 1] = atomicAdd((int*)&cnt[e1], 1);
                rstd_o[row] = rstd;
            }
#pragma unroll
            for (int i = 0; i < 4; ++i) xq[i] = xn[i];
        }
    }
    __syncthreads();
    if (F.tid < 32) ((int*)(F.ws + WS_ROUTE + RT_BCNT))[F.blk * 32 + F.tid] = cnt[F.tid];
}

__device__ __forceinline__ void phase_slots(Ctx& F, int l, int nrows) {
    LAS int* base = (LAS int*)F.lds;
    const int* bc = (const int*)(F.ws + WS_ROUTE + RT_BCNT);
    { const int g = F.tid >> 5, e = F.tid & 31; int tot = 0, below = 0;
      for (int b = g; b < F.nblk; b += 16) { const int c = bc[b * 32 + e]; tot += c; if (b < F.blk) below += c; }
      base[128 + g * 32 + e] = tot; base[640 + g * 32 + e] = below; }
    __syncthreads();
    if (F.tid < 32) { int tot = 0, below = 0;
#pragma unroll
        for (int g = 0; g < 16; ++g) { tot += base[128 + g * 32 + F.tid]; below += base[640 + g * 32 + F.tid]; }
        base[64 + F.tid] = (tot + 255) & ~255; base[F.tid] = below; }
    __syncthreads();
    if (F.tid == 0) { int off = 0; for (int e = 0; e < 32; ++e) { const int p = base[64 + e]; base[32 + e] = off; base[e] += off; off += p; }
        base[96] = off; }
    __syncthreads();
    if (F.blk == 0) { int* te = (int*)(F.ws + WS_ROUTE + RT_TILEE); const int nt = base[96] >> 8;
        for (int t = F.tid; t < nt; t += NTHREADS) { int e = 0; for (int q = 1; q < 32; ++q) if (base[32 + q] <= t * 256) e = q; te[t] = e; }
        if (F.tid == 0) te[320] = nt; }
    const int* tok_e = (const int*)(F.ws + WS_ROUTE + RT_TOKE); const int* tok_r = (const int*)(F.ws + WS_ROUTE + RT_TOKR); int* tok_s = (int*)(F.ws + WS_ROUTE + RT_TOKS);
    int* stok = (int*)(F.ws + WS_STOK);
    for (int i = F.tid; i < 288; i += NTHREADS) { const int row = F.blk * 144 + (i >> 1); if (row < nrows) { const int sl = base[tok_e[row * 2 + (i & 1)]] + tok_r[row * 2 + (i & 1)]; tok_s[row * 2 + (i & 1)] = sl; stok[sl] = row; } }
}

__device__ __forceinline__ void load_yrow(const bf16_t* Y, int sl, int lane, u32x2* y) {
#pragma unroll
    for (int j = 0; j < 4; ++j) y[j] = __builtin_nontemporal_load((const u32x2*)(Y + (size_t)sl * D + 4 * lane + 256 * j));
}
__device__ __forceinline__ void phase_combine(Ctx& F, int l) {
    const int nrows = l == 0 ? NTOK : NL;
    const int* tok_s = (const int*)(F.ws + WS_ROUTE + RT_TOKS); const float* tok_w = (const float*)(F.ws + WS_ROUTE + RT_TOKW);
    const bf16_t* Y = (const bf16_t*)(F.ws + WS_Y); bf16_t* H = (bf16_t*)(F.ws + WS_H);
    const float* mod = (const float*)(F.ws + WS_MOD);
    const int r0 = (F.blk * NWAVES + F.wave) * 18, r1 = r0 + 18 < nrows ? r0 + 18 : nrows; int curb = -1; RowMod M; float g2[16];
    float fg[16];
    if (l == 1) load_row16(F.in[I_FINALG], F.lane, fg);
    if (r0 >= r1) return;
    float nx[16]; u32x2 ny0[4], ny1[4]; float nw0, nw1; int ps0, ps1; float pw0, pw1;
    { const int sa = tok_s[r0 * 2], sb = tok_s[r0 * 2 + 1]; nw0 = tok_w[r0 * 2]; nw1 = tok_w[r0 * 2 + 1];
      load_row16_bf16_nt(xrow_cur(F, r0), F.lane, nx); load_yrow(Y, sa, F.lane, ny0); load_yrow(Y, sb, F.lane, ny1);
      const int rn = r0 + 1 < r1 ? r0 + 1 : r0; ps0 = tok_s[rn * 2]; ps1 = tok_s[rn * 2 + 1]; pw0 = tok_w[rn * 2]; pw1 = tok_w[rn * 2 + 1]; }
    for (int row = r0; row < r1; ++row) {
        float v[16]; u32x2 y0[4], y1[4]; const float w0 = nw0, w1 = nw1;
#pragma unroll
        for (int i = 0; i < 16; ++i) v[i] = nx[i];
#pragma unroll
        for (int j = 0; j < 4; ++j) { y0[j] = ny0[j]; y1[j] = ny1[j]; }
        { const int rn = row + 1 < r1 ? row + 1 : row, rn2 = row + 2 < r1 ? row + 2 : rn;
          load_row16_bf16_nt(xrow_cur(F, rn), F.lane, nx); load_yrow(Y, ps0, F.lane, ny0); load_yrow(Y, ps1, F.lane, ny1); nw0 = pw0; nw1 = pw1;
          ps0 = tok_s[rn2 * 2]; ps1 = tok_s[rn2 * 2 + 1]; pw0 = tok_w[rn2 * 2]; pw1 = tok_w[rn2 * 2 + 1]; }
        const int b = row < NL ? row >> 11 : 16;
        if (b != curb) { if (l == 0) load_rowmod(F, 1, 0, b, M); load_row16(mod + (size_t)(l * 17 + b) * 6144 + 5 * 1024, F.lane, g2); curb = b; }

#pragma unroll
        for (int j = 0; j < 4; ++j) { const u32x2 a = y0[j], c = y1[j];
            const float q0 = w0 * bf2f(a.x & 0xffffu) + w1 * bf2f(c.x & 0xffffu), q1 = w0 * bf2f(a.x >> 16) + w1 * bf2f(c.x >> 16);
            const float q2 = w0 * bf2f(a.y & 0xffffu) + w1 * bf2f(c.y & 0xffffu), q3 = w0 * bf2f(a.y >> 16) + w1 * bf2f(c.y >> 16);
            v[4 * j] += g2[4 * j] * q0; v[4 * j + 1] += g2[4 * j + 1] * q1; v[4 * j + 2] += g2[4 * j + 2] * q2; v[4 * j + 3] += g2[4 * j + 3] * q3; }
        const float rstd = row_rstd(v);
        if (l == 0) {
            store_row16_bf16(xrow_cur(F, row), F.lane, v);
#pragma unroll
            for (int i = 0; i < 16; ++i) v[i] = v[i] * rstd * M.a[i] + M.s[i];
            store_row16_bf16(H + (size_t)row * D, F.lane, v);
        } else {
#pragma unroll
            for (int i = 0; i < 16; ++i) v[i] = v[i] * rstd * fg[i];
            store_row16_f32_nt(F.out + (size_t)row * D, F.lane, v);
        }
    }
}

struct GemmDesc { const bf16_t* A; int lda; const bf16_t* Bt; int K; int nM, nN; const int* tile_e; size_t estride; const int* gather = nullptr; };

template <class Epi>
__device__ __forceinline__ void gemm_naive(Ctx& F, const GemmDesc g, const Epi& E) {
    const int wr = F.wave >> 2, wc = F.wave & 3, fr = F.lane & 15, fq = F.lane >> 4;
    const int nun = g.nM * g.nN;
    for (int u = F.blk; u < nun; u += F.nblk) {
        const int pm = u / g.nN, pn = u % g.nN;
        const bf16_t* Bt = g.Bt + (g.tile_e ? (size_t)g.tile_e[pm] * g.estride : 0);
        const bf16_t* bp = Bt + (size_t)(256 * pn + 32 * wc + 8 * fq) * g.K;
        for (int am = 0; am < 8; ++am) {
            const int ai = am >> 2, m = am & 3, row = 256 * pm + 128 * ai + 64 * wr + 16 * m + fr;
            const bf16_t* ap = g.A + (size_t)row * g.lda;
            float v0[8], v1[8];
#pragma unroll
            for (int i = 0; i < 8; ++i) { v0[i] = 0.f; v1[i] = 0.f; }
            for (int k0 = 0; k0 < g.K; k0 += 8) {
                float a[8]; unpack8(*(const u32x4*)(ap + k0), a);
#pragma unroll
                for (int i = 0; i < 8; ++i) { float b[8]; unpack8(*(const u32x4*)(bp + (size_t)i * g.K + k0), b);
#pragma unroll
                    for (int q = 0; q < 8; ++q) v0[i] += a[q] * b[q];
                    unpack8(*(const u32x4*)(bp + (size_t)(128 + i) * g.K + k0), b);
#pragma unroll
                    for (int q = 0; q < 8; ++q) v1[i] += a[q] * b[q]; }
            }
            E(row, pn, 32 * wc + 8 * fq, v0, v1);
        }
    }
}


#ifndef EPI_DIST
#define EPI_DIST 2
#endif
struct RopePre { f32x4 t[4]; };
__device__ __forceinline__ void rope_load(int row, int cl, const float* rt, RopePre& P) {
    const int fq = (cl >> 3) & 3, t = row & (SEQ - 1), axis = (cl >> 5) & 1, pos = axis ? (t & 63) : (t >> 6), f0 = 8 * (fq & 1);
    const f32x4* tp = (const f32x4*)(rt + (pos * 16 + f0) * 2);
    P.t[0] = tp[0]; P.t[1] = tp[1]; P.t[2] = tp[2]; P.t[3] = tp[3];
}
__device__ __forceinline__ void rope_apply(float* v, int cl, const RopePre& P) {
    const bool x2 = ((cl >> 3) & 3) >= 2;
    const float cs[16] = {P.t[0][0], P.t[0][1], P.t[0][2], P.t[0][3], P.t[1][0], P.t[1][1], P.t[1][2], P.t[1][3], P.t[2][0], P.t[2][1], P.t[2][2], P.t[2][3], P.t[3][0], P.t[3][1], P.t[3][2], P.t[3][3]};
#pragma unroll
    for (int i = 0; i < 8; ++i) { const unsigned u = __float_as_uint(v[i]); auto rr = __builtin_amdgcn_permlane32_swap(u, u, false, false);
        const float p = __uint_as_float(x2 ? rr[0] : rr[1]); const float c = cs[2 * i], sn = cs[2 * i + 1];
        v[i] = x2 ? v[i] * c + p * sn : v[i] * c - p * sn; }
}
struct RopeUnit { bool rope; float sc; };
struct EpiIn0 { static constexpr bool PREFETCH = true; static constexpr int NPRE = EPI_DIST; typedef RopePre Pre; typedef RopeUnit UPre; bf16_t* O; const float* rt;
    __device__ __forceinline__ void uload(int pm, int pn, int cl, UPre& G) const { G.rope = pn < 4 && pm * 256 < NL; G.sc = (pn == 2 || pn == 3) ? 0.125f : ((pn == 8 || pn == 9) ? 0.125f * LOG2E : 1.f); }
    __device__ __forceinline__ bool variant(const UPre& G) const { return G.rope; }
    template <bool R> __device__ __forceinline__ void load(int row, int pn, int cl, Pre& P, const UPre& G) const { if constexpr (R) rope_load(row, cl, rt, P); }
    template <bool R> __device__ __forceinline__ void apply(int row, int pn, int cl, float* v0, float* v1, const Pre& P, const UPre& G) const {
        if constexpr (R) { rope_apply(v0, cl, P); rope_apply(v1, cl, P); }
#pragma unroll
        for (int i = 0; i < 8; ++i) { v0[i] *= G.sc; v1[i] *= G.sc; }
        bf16_t* p = O + (size_t)row * ABIN + 256 * pn + cl; store8_bf16(p, v0); store8_bf16(p + 128, v1);
    } };
struct EpiIn1 { static constexpr bool PREFETCH = true; static constexpr int NPRE = EPI_DIST; typedef RopePre Pre; typedef RopeUnit UPre; bf16_t* O; const float* rt; int col0; int rowoff;
    __device__ __forceinline__ void uload(int pm, int pn, int cl, UPre& G) const { G.rope = rowoff + pm * 256 < NL && col0 + 256 * pn < 1280; G.sc = col0 + 256 * pn < 1024 ? 0.125f * LOG2E : 1.f; }
    __device__ __forceinline__ bool variant(const UPre& G) const { return G.rope; }
    template <bool R> __device__ __forceinline__ void load(int row, int pn, int cl, Pre& P, const UPre& G) const { if constexpr (R) rope_load(row + rowoff, cl, rt, P); }
    template <bool R> __device__ __forceinline__ void apply(int row, int pn, int cl, float* v0, float* v1, const Pre& P, const UPre& G) const {
        const int c = col0 + 256 * pn; row += rowoff;
        if constexpr (R) { rope_apply(v0, cl, P); rope_apply(v1, cl, P); }
#pragma unroll
        for (int i = 0; i < 8; ++i) { v0[i] *= G.sc; v1[i] *= G.sc; }
        bf16_t* p = O + (size_t)row * SWAIN + c + cl; store8_bf16(p, v0); store8_bf16(p + 128, v1);
    } };
struct EpiResPre { float xo[16]; };
struct EpiResUnit { f32x4 g[4]; const float* xsrc; };
template <bool L0>
struct EpiResT { static constexpr bool PREFETCH = true; static constexpr int NPRE = L0 ? EPI_DIST : 4; typedef EpiResPre Pre; typedef EpiResUnit UPre; const float* xl; const float* xc; bf16_t* xb; const float* mod;
    __device__ __forceinline__ void uload(int pm, int pn, int cl, UPre& G) const { const int b = pm * 256 < NL ? pm >> 3 : 16; const float* g = mod + (size_t)b * 6144 + 2048 + 256 * pn + cl;
        G.g[0] = *(const f32x4*)g; G.g[1] = *(const f32x4*)(g + 4); G.g[2] = *(const f32x4*)(g + 128); G.g[3] = *(const f32x4*)(g + 132);
        G.xsrc = nullptr; if constexpr (L0) G.xsrc = pm * 256 < NL ? xl + (size_t)pm * 256 * D : xc + ((size_t)pm * 256 - NL) * D; }
    __device__ __forceinline__ bool variant(const UPre&) const { return false; }
    template <bool R> __device__ __forceinline__ void load(int row, int pn, int cl, Pre& P, const UPre& G) const {
#pragma unroll
        for (int h = 0; h < 2; ++h) { const int c = 256 * pn + cl + 128 * h;
            if constexpr (L0) { const float* src = G.xsrc + (size_t)(row & 255) * D + c;
                const f32x4 x0 = __builtin_nontemporal_load((const f32x4*)src), x1 = __builtin_nontemporal_load((const f32x4*)(src + 4)); P.xo[8 * h] = x0[0]; P.xo[8 * h + 1] = x0[1]; P.xo[8 * h + 2] = x0[2]; P.xo[8 * h + 3] = x0[3]; P.xo[8 * h + 4] = x1[0]; P.xo[8 * h + 5] = x1[1]; P.xo[8 * h + 6] = x1[2]; P.xo[8 * h + 7] = x1[3]; }
            else unpack8(*(const u32x4*)(xb + (size_t)row * D + c), P.xo + 8 * h); } }
    template <bool R> __device__ __forceinline__ void apply(int row, int pn, int cl, float* v0, float* v1, const Pre& P, const UPre& G) const {
        bf16_t* dst = xb + (size_t)row * D;
#pragma unroll
        for (int h = 0; h < 2; ++h) { float* v = h ? v1 : v0; const int c = 256 * pn + cl + 128 * h;
            const f32x4 g0 = G.g[2 * h], g1 = G.g[2 * h + 1]; float o[8];
#pragma unroll
            for (int i = 0; i < 4; ++i) { o[i] = P.xo[8 * h + i] + g0[i] * v[i]; o[4 + i] = P.xo[8 * h + 4 + i] + g1[i] * v[4 + i]; }
            store8_bf16(dst + c, o); } }
};
struct EpiGU { bf16_t* O;
    __device__ __forceinline__ void operator()(int row, int pn, int cl, float* v0, float* v1) const {
        float a[8];
#pragma unroll
        for (int i = 0; i < 8; ++i) a[i] = v0[i] * __builtin_amdgcn_rcpf(1.f + __builtin_amdgcn_exp2f(-LOG2E * v0[i])) * v1[i];
        store8_bf16(O + (size_t)row * FF + 128 * pn + cl, a);
    } };
struct EpiY { bf16_t* O;
    __device__ __forceinline__ void operator()(int row, int pn, int cl, float* v0, float* v1) const {
        bf16_t* p = O + (size_t)row * D + 256 * pn + cl; store8_bf16(p, v0); store8_bf16(p + 128, v1);
    } };


struct EpiResPre;
namespace pg8 {
#define PG8_LAS __attribute__((address_space(3)))
typedef short bf16x8 __attribute__((ext_vector_type(8)));
constexpr int BM = 256, BK = 64, HALF = 128, HTB = HALF * BK * 2, STAGE_BYTES = 8 * HTB, NXCD = 8, WGM = 8;
__host__ __device__ __forceinline__ int lds_byte(int r, int c) { const int st = (r >> 4) * 2 + (c >> 5), rr = r & 15, cc = c & 31, ob = rr * 64 + cc * 2; return st * 1024 + (ob ^ (((ob >> 9) & 1) << 5)); }
__host__ __device__ __forceinline__ void stage_rc(int b, int& R, int& C) { const int st = b / 1024, sb = b % 1024, swz = sb ^ (((sb >> 9) & 1) << 5); R = (st >> 1) * 16 + swz / 64; C = (st & 1) * 32 + (swz % 64) / 2; }
__host__ __device__ __forceinline__ int perm32(int rho) { const int n = rho >> 4, i = rho & 15; return 8 * (i >> 2) + 4 * n + (i & 3); }
struct Unit { int pm, pn; };
struct Gemm { const bf16_t* A; const bf16_t* Bt; int K; const int* tile_e; size_t estride; const int* gather; };
__device__ __forceinline__ const char* unit_b(const Gemm& g, const Unit& u, size_t tstep) {
    const bf16_t* b = g.Bt; if (g.tile_e) b += (size_t)g.tile_e[u.pm] * g.estride; return (const char*)b + (size_t)u.pn * tstep; }
struct StaticOrder {
    int nM, nN, nwg, G, c;
    __device__ void init(int nM_, int nN_, int G_, int c_) { nM = nM_; nN = nN_; nwg = nM * nN; G = G_; c = c_; }
    __device__ bool next(int i, Unit& u) const {
        const long L = (long)i * G + c; if (L >= nwg) return false;
        int wgid = (int)L; { const int q = nwg / NXCD, r = nwg % NXCD, xcd = wgid % NXCD, off = wgid / NXCD; wgid = (xcd < r ? xcd * (q + 1) : r * (q + 1) + (xcd - r) * q) + off; }
        const int nig = WGM * nN, gid = wgid / nig, fm = gid * WGM, gsz = (nM - fm) < WGM ? (nM - fm) : WGM;
        u.pm = fm + ((wgid % nig) % gsz); u.pn = (wgid % nig) / gsz; return true;
    }
    __device__ __forceinline__ void a_ready(const Unit&) const {}
    __device__ __forceinline__ void done(const Unit&) const {}
};
template <class Epi> struct epi_has_prefetch { template <class T> static constexpr bool test(decltype(T::PREFETCH)*) { return T::PREFETCH; } template <class T> static constexpr bool test(...) { return false; } static constexpr bool value = test<Epi>(nullptr); };
template <class Epi, bool V>
__device__ __forceinline__ void run_epi_pre(const f32x4 (&acc)[2][2][4][2], const Unit& u, int wr, int wc, int fr, int fq, const Epi& E, const typename Epi::UPre& G) {
    constexpr int DIST = Epi::NPRE, NS = DIST + 1;
    typename Epi::Pre P[NS];
#pragma unroll
    for (int am = 0; am < DIST; ++am) E.template load<V>(u.pm * BM + (am >> 2) * HALF + wr * 64 + (am & 3) * 16 + fr, u.pn, wc * 32 + fq * 8, P[am % NS], G);
#pragma unroll
    for (int r = 0; r < 8; ++r) {
        if (r + DIST < 8) { const int am = r + DIST; E.template load<V>(u.pm * BM + (am >> 2) * HALF + wr * 64 + (am & 3) * 16 + fr, u.pn, wc * 32 + fq * 8, P[am % NS], G); }
        const int ai = r >> 2, m = r & 3; const int row = u.pm * BM + ai * HALF + wr * 64 + m * 16 + fr; float v0[8], v1[8];
#pragma unroll
        for (int i = 0; i < 4; ++i) { v0[i] = acc[ai][0][m][0][i]; v0[4 + i] = acc[ai][0][m][1][i]; v1[i] = acc[ai][1][m][0][i]; v1[4 + i] = acc[ai][1][m][1][i]; }
        E.template apply<V>(row, u.pn, wc * 32 + fq * 8, v0, v1, P[r % NS], G);
    }
}
template <class Epi>
__device__ __forceinline__ void run_epi(const f32x4 (&acc)[2][2][4][2], const Unit& u, int wr, int wc, int fr, int fq, const Epi& E) {
    if constexpr (epi_has_prefetch<Epi>::value) {
        typename Epi::UPre G; E.uload(u.pm, u.pn, wc * 32 + fq * 8, G);
        if (E.variant(G)) run_epi_pre<Epi, true>(acc, u, wr, wc, fr, fq, E, G); else run_epi_pre<Epi, false>(acc, u, wr, wc, fr, fq, E, G);
    } else {
#pragma unroll
        for (int ai = 0; ai < 2; ++ai) {
#pragma unroll
            for (int m = 0; m < 4; ++m) { const int row = u.pm * BM + ai * HALF + wr * 64 + m * 16 + fr; float v0[8], v1[8];
#pragma unroll
                for (int i = 0; i < 4; ++i) { v0[i] = acc[ai][0][m][0][i]; v0[4 + i] = acc[ai][0][m][1][i]; v1[i] = acc[ai][1][m][0][i]; v1[4 + i] = acc[ai][1][m][1][i]; }
                E(row, u.pn, wc * 32 + fq * 8, v0, v1); }
        }
    }
}
template <class Epi, class Sched, bool ALIGN_EPI = false, bool SP2 = false>
__device__ __forceinline__ void gemm_phase(PG8_LAS unsigned char* lds, const Gemm g, const Sched& S, const Epi& E, const int tid_in) {
    const int tid = tid_in, wid = __builtin_amdgcn_readfirstlane(tid >> 6), lane = tid & 63, wr = wid >> 2, wc = wid & 3, fr = lane & 15, fq = lane >> 4;
    const int K = g.K, nt = K / BK;
    unsigned voffA[2], voffB[2];
#pragma unroll
    for (int i = 0; i < 2; ++i) { int R, C; stage_rc(tid * 16 + i * 8192, R, C); const int Rb = ((R & ~31) + perm32(R & 31));
        voffA[i] = (unsigned)(R * K + C) * 2u; voffB[i] = (unsigned)(Rb * K + C) * 2u; }
    unsigned voC[2][2], voN[2][2]; int gR[2], gC[2];
#pragma unroll
    for (int i = 0; i < 2; ++i) { int R, C; stage_rc(tid * 16 + i * 8192, R, C); gR[i] = R; gC[i] = C; voC[0][i] = voC[1][i] = voN[0][i] = voN[1][i] = voffA[i]; }
    const size_t kstep = (size_t)(BK * 2);
    const size_t hstep = (size_t)HALF * K * 2;
    const size_t tstep = 2 * hstep;
    const size_t ahs = g.gather ? 0 : hstep;
#define PG8_GATHER(vo, unit) do { if (g.gather) { _Pragma("unroll") for (int h_ = 0; h_ < 2; ++h_) _Pragma("unroll") for (int i_ = 0; i_ < 2; ++i_) { \
        const int tk_ = g.gather[(unit).pm * BM + h_ * HALF + gR[i_]]; (vo)[h_][i_] = (unsigned)(((unsigned)tk_ < (unsigned)NTOK ? tk_ : 0) * K + gC[i_]) * 2u; } } } while (0)
    const unsigned ldsw = (unsigned)wid * 1024u;
    const int aoff = lds_byte(wr * 64 + fr, fq * 8), boff = lds_byte(wc * 32 + fr, fq * 8);
#define PG8_SA(b, h) (((b) * 2 + (h)) * HTB)
#define PG8_SB(b, h) ((4 + (b) * 2 + (h)) * HTB)
#define PG8_STAGE(bufoff, gbase, voff) do { _Pragma("unroll") for (int _i = 0; _i < 2; ++_i) \
        __builtin_amdgcn_global_load_lds((const unsigned*)((const char*)(gbase) + (voff)[_i]), (PG8_LAS unsigned*)(lds + (bufoff) + ldsw + _i * 8192), 16, 0, 0); } while (0)
#define PG8_LDA(dst, b, h) do { _Pragma("unroll") for (int m = 0; m < 4; ++m) _Pragma("unroll") for (int k = 0; k < 2; ++k) dst[m][k] = *(const PG8_LAS bf16x8*)(lds + PG8_SA(b, h) + aoff + m * 2048 + k * 1024); } while (0)
#define PG8_LDB(dst, b, h) do { _Pragma("unroll") for (int n = 0; n < 2; ++n) _Pragma("unroll") for (int k = 0; k < 2; ++k) dst[n][k] = *(const PG8_LAS bf16x8*)(lds + PG8_SB(b, h) + boff + n * 2048 + k * 1024); } while (0)
#define PG8_MMA(ai, bj, At, Bt) do { __builtin_amdgcn_s_setprio(1); _Pragma("unroll") for (int m = 0; m < 4; ++m) _Pragma("unroll") for (int n = 0; n < 2; ++n) _Pragma("unroll") for (int k = 0; k < 2; ++k) \
        acc[ai][bj][m][n] = __builtin_amdgcn_mfma_f32_16x16x32_bf16(Bt[n][k], At[m][k], acc[ai][bj][m][n], 0, 0, 0); __builtin_amdgcn_s_setprio(0); } while (0)
#define PG8_WAIT_V(n) asm volatile("s_waitcnt vmcnt(" #n ")" ::: "memory")
#define PG8_WAIT_L(n) asm volatile("s_waitcnt lgkmcnt(" #n ")" ::: "memory")
#define PG8_BAR __builtin_amdgcn_s_barrier()
#define PG8_SCHED __builtin_amdgcn_sched_barrier(0)
    Unit cur, nxt; int ui = 0;
    if (!S.next(0, cur)) return;
    f32x4 acc[2][2][4][2];
#pragma unroll
    for (int a = 0; a < 2; ++a)
#pragma unroll
        for (int b = 0; b < 2; ++b)
#pragma unroll
            for (int m = 0; m < 4; ++m)
#pragma unroll
                for (int n = 0; n < 2; ++n) acc[a][b][m][n] = (f32x4){0.f, 0.f, 0.f, 0.f};
    bf16x8 At[4][2], B0[2][2], B1[2][2];
    const char* cA = g.gather ? (const char*)g.A : (const char*)g.A + (size_t)cur.pm * tstep; const char* cB = unit_b(g, cur, tstep);
    PG8_GATHER(voC, cur);
    S.a_ready(cur);
    if constexpr (SP2) {
        PG8_STAGE(PG8_SB(0, 0), cB, voffB); PG8_STAGE(PG8_SB(0, 1), cB + hstep, voffB); PG8_STAGE(PG8_SA(0, 0), cA, voC[0]); PG8_STAGE(PG8_SA(0, 1), cA + ahs, voC[1]);
        if (wr == 1) PG8_BAR;
        PG8_WAIT_V(2); PG8_BAR;
        PG8_STAGE(PG8_SB(1, 0), cB + kstep, voffB); PG8_STAGE(PG8_SA(1, 0), cA + kstep, voC[0]); PG8_STAGE(PG8_SB(1, 1), cB + hstep + kstep, voffB);
        PG8_WAIT_V(6); PG8_BAR;
    } else {
        PG8_STAGE(PG8_SB(0, 0), cB, voffB); PG8_STAGE(PG8_SA(0, 0), cA, voC[0]); PG8_STAGE(PG8_SB(0, 1), cB + hstep, voffB); PG8_STAGE(PG8_SA(0, 1), cA + ahs, voC[1]);
        if (wr == 1) PG8_BAR;
        PG8_WAIT_V(4); PG8_BAR;
        PG8_STAGE(PG8_SB(1, 0), cB + kstep, voffB); PG8_STAGE(PG8_SA(1, 0), cA + kstep, voC[0]); PG8_STAGE(PG8_SB(1, 1), cB + hstep + kstep, voffB);
        PG8_WAIT_V(6); PG8_BAR;
    }
    for (;;) {
        const bool has_next = S.next(ui + 1, nxt);
        const char* nA = (has_next && !g.gather) ? (const char*)g.A + (size_t)nxt.pm * tstep : cA; const char* nB = has_next ? unit_b(g, nxt, tstep) : cB;
        if (has_next) PG8_GATHER(voN, nxt);
        for (int t = 0; t < nt; t += 2) {
            const bool last = (t == nt - 2);
            const char* a1 = cA + (size_t)(t + 1) * kstep;
            const char* a2 = last ? nA : cA + (size_t)(t + 2) * kstep; const char* b2 = last ? nB : cB + (size_t)(t + 2) * kstep;
            const char* a3 = a2 + kstep; const char* b3 = b2 + kstep;
            unsigned v2[2][2];
#pragma unroll
            for (int h_ = 0; h_ < 2; ++h_)
#pragma unroll
                for (int i_ = 0; i_ < 2; ++i_) v2[h_][i_] = last ? voN[h_][i_] : voC[h_][i_];
            if (last && has_next) S.a_ready(nxt);
            if constexpr (SP2) {
            PG8_LDB(B0, 0, 0); PG8_LDB(B1, 0, 1); PG8_SCHED; PG8_LDA(At, 0, 0); PG8_STAGE(PG8_SA(1, 1), a1 + ahs, voC[1]);
            PG8_WAIT_V(8); PG8_WAIT_L(0); PG8_BAR; PG8_MMA(0, 0, At, B0); PG8_MMA(0, 1, At, B1); PG8_BAR; PG8_SCHED;
            PG8_LDA(At, 0, 1); PG8_STAGE(PG8_SB(0, 0), b2, voffB); PG8_STAGE(PG8_SB(0, 1), b2 + hstep, voffB); PG8_STAGE(PG8_SA(0, 0), a2, v2[0]);
            PG8_WAIT_V(8); PG8_WAIT_L(0); PG8_BAR; PG8_MMA(1, 0, At, B0); PG8_MMA(1, 1, At, B1); PG8_BAR; PG8_SCHED;
            PG8_LDB(B0, 1, 0); PG8_LDB(B1, 1, 1); PG8_SCHED; PG8_LDA(At, 1, 0); PG8_STAGE(PG8_SA(0, 1), a2 + ahs, v2[1]);
            PG8_WAIT_V(8); PG8_WAIT_L(0); PG8_BAR; PG8_MMA(0, 0, At, B0); PG8_MMA(0, 1, At, B1); PG8_BAR; PG8_SCHED;
            PG8_LDA(At, 1, 1); PG8_STAGE(PG8_SB(1, 0), b3, voffB); PG8_STAGE(PG8_SB(1, 1), b3 + hstep, voffB); PG8_STAGE(PG8_SA(1, 0), a3, v2[0]);
            PG8_WAIT_V(8); PG8_WAIT_L(0); PG8_BAR; PG8_MMA(1, 0, At, B0); PG8_MMA(1, 1, At, B1); PG8_BAR; PG8_SCHED;
            } else {
            PG8_LDB(B0, 0, 0); PG8_SCHED; PG8_LDA(At, 0, 0); PG8_STAGE(PG8_SA(1, 1), a1 + ahs, voC[1]);
            PG8_WAIT_L(8); PG8_BAR; PG8_WAIT_L(0); PG8_MMA(0, 0, At, B0); PG8_BAR; PG8_SCHED;
            PG8_LDB(B1, 0, 1); PG8_STAGE(PG8_SB(0, 0), b2, voffB);
            PG8_BAR; PG8_WAIT_L(0); PG8_MMA(0, 1, At, B1); PG8_BAR;
            PG8_LDA(At, 0, 1); PG8_STAGE(PG8_SA(0, 0), a2, v2[0]);
            PG8_BAR; PG8_WAIT_L(0); PG8_MMA(1, 0, At, B0); PG8_BAR; PG8_SCHED;
            PG8_STAGE(PG8_SB(0, 1), b2 + hstep, voffB);
            PG8_WAIT_V(6); PG8_BAR; PG8_MMA(1, 1, At, B1); PG8_BAR;
            PG8_LDB(B0, 1, 0); PG8_SCHED; PG8_LDA(At, 1, 0); PG8_STAGE(PG8_SA(0, 1), a2 + ahs, v2[1]);
            PG8_WAIT_L(8); PG8_BAR; PG8_WAIT_L(0); PG8_MMA(0, 0, At, B0); PG8_BAR; PG8_SCHED;
            PG8_LDB(B1, 1, 1); PG8_STAGE(PG8_SB(1, 0), b3, voffB);
            PG8_BAR; PG8_WAIT_L(0); PG8_MMA(0, 1, At, B1); PG8_BAR;
            PG8_LDA(At, 1, 1); PG8_STAGE(PG8_SA(1, 0), a3, v2[0]);
            PG8_BAR; PG8_WAIT_L(0); PG8_MMA(1, 0, At, B0); PG8_BAR; PG8_SCHED;
            PG8_STAGE(PG8_SB(1, 1), b3 + hstep, voffB);
            PG8_WAIT_V(6); PG8_BAR; PG8_MMA(1, 1, At, B1); PG8_BAR;
            }
        }
        if constexpr (ALIGN_EPI) { if (wr == 0) PG8_BAR; }
        run_epi(acc, cur, wr, wc, fr, fq, E); S.done(cur);
        if (!has_next) break;
#pragma unroll
        for (int a = 0; a < 2; ++a)
#pragma unroll
            for (int b = 0; b < 2; ++b)
#pragma unroll
                for (int m = 0; m < 4; ++m)
#pragma unroll
                    for (int n = 0; n < 2; ++n) acc[a][b][m][n] = (f32x4){0.f, 0.f, 0.f, 0.f};
        cur = nxt; cA = nA; cB = nB; ++ui;
#pragma unroll
        for (int h_ = 0; h_ < 2; ++h_)
#pragma unroll
            for (int i_ = 0; i_ < 2; ++i_) voC[h_][i_] = voN[h_][i_];
        if constexpr (ALIGN_EPI) { if (wr == 1) PG8_BAR; }
    }
    PG8_WAIT_V(0);
    if constexpr (!ALIGN_EPI) { if (wr == 0) PG8_BAR; }
    PG8_BAR;
#undef PG8_GATHER
#undef PG8_SA
#undef PG8_SB
#undef PG8_STAGE
#undef PG8_LDA
#undef PG8_LDB
#undef PG8_MMA
#undef PG8_WAIT_V
#undef PG8_WAIT_L
#undef PG8_BAR
#undef PG8_SCHED
}
}


#ifndef GEMM_NAIVE
#define GEMM_NAIVE 0
#endif
template <class Epi>
__device__ __forceinline__ void gemm_run(Ctx& F, const GemmDesc g, const Epi& E) {
#if GEMM_NAIVE
    gemm_naive(F, g, E);
#else
    pg8::Gemm pg{g.A, g.Bt, g.K, g.tile_e, g.estride, g.gather}; pg8::StaticOrder S; S.init(g.nM, g.nN, F.nblk, F.blk);
    pg8::gemm_phase<Epi, pg8::StaticOrder, true, true>(F.lds, pg, S, E, F.tid);
    __syncthreads();
#endif
}
__device__ __forceinline__ void load_vec64(const bf16_t* p, float* v) {
#pragma unroll
    for (int j = 0; j < 8; ++j) unpack8(*(const u32x4*)(p + 8 * j), v + 8 * j);
}
__device__ __forceinline__ float dot64(const float* q, const bf16_t* kp) {
    float s = 0.f;
#pragma unroll
    for (int j = 0; j < 8; ++j) { float k[8]; unpack8(*(const u32x4*)(kp + 8 * j), k);
#pragma unroll
        for (int i = 0; i < 8; ++i) s += q[8 * j + i] * k[i]; }
    return s;
}
__device__ __forceinline__ void axpy64(float* o, float al, float p, const bf16_t* vp) {
#pragma unroll
    for (int j = 0; j < 8; ++j) { float v[8]; unpack8(*(const u32x4*)(vp + 8 * j), v);
#pragma unroll
        for (int i = 0; i < 8; ++i) o[8 * j + i] = o[8 * j + i] * al + p * v[i]; }
}
__device__ __forceinline__ void attend(const float* q, float* o, float& m, float& l, const bf16_t* kp, const bf16_t* vp, float bias) {
    const float s = bias + dot64(q, kp);
    const float mn = fmaxf(m, s), al = exp2f(m - mn), p = exp2f(s - mn); l = l * al + p; m = mn;
    axpy64(o, al, p, vp);
}
__device__ __forceinline__ void store_vec64_scaled(bf16_t* p, const float* o, float sc) {
#pragma unroll
    for (int j = 0; j < 8; ++j) { float t[8];
#pragma unroll
        for (int i = 0; i < 8; ++i) t[i] = o[8 * j + i] * sc;
        store8_bf16(p + 8 * j, t); }
}
__device__ __forceinline__ void naive_retention(Ctx& F) {
    const bf16_t* QKV = (const bf16_t*)(F.ws + WS_QKV); bf16_t* MIX = (bf16_t*)(F.ws + WS_MIX);
    const int total = NB * 8 * 2304;
    for (int idx = F.blk * NTHREADS + F.tid; idx < total; idx += F.nblk * NTHREADS) {
        const int n = idx % 2304, bh = idx / 2304, h = bh & 7, b = bh >> 3;
        const float df = F.in[I_RETDEC][h], db = F.in[I_RETDEC][8 + h];
        const float lgf = log1pf(-exp2f(-df)) * LOG2E, lgb = log1pf(-exp2f(-db)) * LOG2E;
        const size_t rowc = (size_t)NL + b * CTXL, rowl = (size_t)b * SEQ;
        const size_t myrow = n < 256 ? rowc + n : rowl + (n - 256);
        float q[64], o[64]; load_vec64(QKV + myrow * ABIN + h * 64, q);
#pragma unroll
        for (int i = 0; i < 64; ++i) o[i] = 0.f;
        for (int m = 0; m < 2304; ++m) {
            float w = 0.f;
            if (n < 256) { if (m < 256) { if (m <= n) w += exp2f(lgf * (float)(n - m)); if (m >= n) w += exp2f(lgb * (float)(m - n)); } else continue; }
            else { const int t = n - 256;
                if (m < 256) w = exp2f(lgf * (float)(n - m)) + exp2f(lgb * (float)(2048 - t + m));
                else { const int t2 = m - 256; if (t2 <= t) w += exp2f(lgf * (float)(t - t2)); if (t2 >= t) w += exp2f(lgb * (float)(t2 - t)); } }
            const size_t r = m < 256 ? rowc + m : rowl + (m - 256);
            const float s = w * dot64(q, QKV + r * ABIN + 512 + h * 64);
            axpy64(o, 1.f, s, QKV + r * ABIN + 1024 + h * 64);
        }
        float mu = 0.f;
#pragma unroll
        for (int i = 0; i < 64; ++i) mu += o[i];
        mu *= (1.f / 64.f); float var = 0.f;
#pragma unroll
        for (int i = 0; i < 64; ++i) { o[i] -= mu; var += o[i] * o[i]; }
        const float rs = rsqrtf(var * (1.f / 64.f) + 1e-5f);
#pragma unroll
        for (int j = 0; j < 8; ++j) { float g[8], t[8]; unpack8(*(const u32x4*)(QKV + myrow * ABIN + 1536 + h * 64 + 8 * j), g);
#pragma unroll
            for (int i = 0; i < 8; ++i) t[i] = o[8 * j + i] * rs * F.in[I_RETGN][h * 64 + 8 * j + i] * silu_f(g[i]);
            store8_bf16(MIX + myrow * D + h * 64 + 8 * j, t); }
    }
}
__device__ __forceinline__ void naive_na(Ctx& F) {
    const bf16_t* QKV = (const bf16_t*)(F.ws + WS_QKV); bf16_t* MIX = (bf16_t*)(F.ws + WS_MIX);
    const int total = NB * 8 * 2304;
    for (int idx = F.blk * NTHREADS + F.tid; idx < total; idx += F.nblk * NTHREADS) {
        const int n = idx % 2304, bh = idx / 2304, h = bh & 7, b = bh >> 3;
        const size_t rowc = (size_t)NL + b * CTXL, rowl = (size_t)b * SEQ;
        const size_t myrow = n < 2048 ? rowl + n : rowc + (n - 2048);
        float q[64], o[64]; load_vec64(QKV + myrow * ABIN + 2048 + h * 64, q);
#pragma unroll
        for (int i = 0; i < 64; ++i) o[i] = 0.f;
        float m = -1e30f, l = 0.f;
        if (n < 2048) { const int r = n >> 6, c = n & 63; int rs = r - 4; rs = rs < 0 ? 0 : (rs > 24 ? 24 : rs); int win = c - 8; win = win < 0 ? 0 : (win > 48 ? 48 : win);
            const float* rpb = F.in[I_RPB] + (size_t)h * 15 * 31;
            for (int i = 0; i < 8; ++i) for (int j = 0; j < 16; ++j) { const int kr = rs + i, kc = win + j; const size_t kro = rowl + kr * 64 + kc;
                attend(q, o, m, l, QKV + kro * ABIN + 2560 + h * 64, QKV + kro * ABIN + 3072 + h * 64, rpb[(kr - r + 7) * 31 + (kc - c + 15)] * LOG2E); } }
        for (int j = 0; j < 256; ++j) { const size_t kro = rowc + j; attend(q, o, m, l, QKV + kro * ABIN + 2560 + h * 64, QKV + kro * ABIN + 3072 + h * 64, 0.f); }
        store_vec64_scaled(MIX + myrow * D + 512 + h * 64, o, 1.f / l);
    }
}
__device__ __forceinline__ void naive_swa(Ctx& F) {
    const bf16_t* QKV = (const bf16_t*)(F.ws + WS_QKV); bf16_t* MIX = (bf16_t*)(F.ws + WS_MIX);
    const int total = NB * 16 * 2048;
    for (int idx = F.blk * NTHREADS + F.tid; idx < total; idx += F.nblk * NTHREADS) {
        const int t = idx & 2047, bh = idx >> 11, h = bh & 15, b = bh >> 4, kv = h >> 2;
        const size_t rowc = (size_t)NL + b * CTXL, rowl = (size_t)b * SEQ;
        float q[64], o[64]; load_vec64(QKV + (rowl + t) * SWAIN + h * 64, q);
#pragma unroll
        for (int i = 0; i < 64; ++i) o[i] = 0.f;
        float m = F.in[I_SINK][h] * LOG2E, l = 1.f;
        const int lo = t - 128 < 0 ? 0 : t - 128, hi = t + 128 > 2047 ? 2047 : t + 128;
        for (int j = lo; j <= hi; ++j) attend(q, o, m, l, QKV + (rowl + j) * SWAIN + 1024 + kv * 64, QKV + (rowl + j) * SWAIN + 1280 + kv * 64, 0.f);
        for (int j = 0; j < 256; ++j) attend(q, o, m, l, QKV + (rowc + j) * SWAIN + 1024 + kv * 64, QKV + (rowc + j) * SWAIN + 1280 + kv * 64, 0.f);
        store_vec64_scaled(MIX + (rowl + t) * D + h * 64, o, 1.f / l);
    }
}


typedef float f32x16 __attribute__((ext_vector_type(16)));
typedef short s16x4 __attribute__((ext_vector_type(4)));
__device__ __forceinline__ int crow(int r, int hi) { return (r & 3) + 8 * (r >> 2) + 4 * hi; }
__device__ __forceinline__ s16x4 vtr(const LAS char* p) { return __builtin_bit_cast(s16x4, __builtin_amdgcn_ds_read_tr16_b64_v4i16((LAS s16x4*)p)); }
__device__ __forceinline__ unsigned cvtpk(float lo, float hi) { typedef float f2 __attribute__((ext_vector_type(2))); typedef __bf16 b2 __attribute__((ext_vector_type(2)));
    f2 v = {lo, hi}; b2 b = __builtin_convertvector(v, b2); return __builtin_bit_cast(unsigned, b); }
__device__ __forceinline__ float swapmax(float v) { auto rr = __builtin_amdgcn_permlane32_swap(__float_as_uint(v), __float_as_uint(v), false, false); return fmaxf(__uint_as_float(rr[0]), __uint_as_float(rr[1])); }
__device__ __forceinline__ float swapsum(float v) { auto rr = __builtin_amdgcn_permlane32_swap(__float_as_uint(v), __float_as_uint(v), false, false); return __uint_as_float(rr[0]) + __uint_as_float(rr[1]); }
constexpr int FA_WAVE_LDS = 15104;
constexpr int FA_V = 8192, FA_SCR = 12288, FA_BIAS = 12544;

struct FaTile { unsigned k; int mode, p0, p1, p2; };
__device__ __forceinline__ void fa_uniform(FaTile& T) { T.k = __builtin_amdgcn_readfirstlane(T.k); T.mode = __builtin_amdgcn_readfirstlane(T.mode); T.p0 = __builtin_amdgcn_readfirstlane(T.p0); T.p1 = __builtin_amdgcn_readfirstlane(T.p1); T.p2 = __builtin_amdgcn_readfirstlane(T.p2); }
struct FaAcc { f32x16 o[2][2]; float m[2], l[2]; };

__device__ __forceinline__ void fa_load_k(const bf16_t* base, const FaTile& T, int ld, int lane, bf16x8* kf) {
    const int r32 = lane & 31, hi = lane >> 5; const bf16_t* p = base + T.k;
#pragma unroll
    for (int ds = 0; ds < 4; ++ds) kf[ds] = *(const bf16x8*)(p + (unsigned)(r32 * ld + 16 * ds + 8 * hi));
}
__device__ __forceinline__ void fa_load_v(const bf16_t* base, const FaTile& T, int ld, int lane, u32x4* vr) {
    const bf16_t* p = base + T.k;
#pragma unroll
    for (int i = 0; i < 4; ++i) { const int c = lane + 64 * i; vr[i] = *(const u32x4*)(p + (unsigned)((c >> 3) * ld + (c & 7) * 8)); }
}
__device__ __forceinline__ void fa_tile(const FaTile& T, const bf16x8* kf, const u32x4* vr, FaAcc& A, LAS char* wl, int lane) {
    const int r32 = lane & 31, hi = lane >> 5;
    LAS float* scr = (LAS float*)(wl + FA_SCR); const LAS float* bias = (const LAS float*)(wl + FA_BIAS);
    bf16x8 pf[2][2];
#pragma unroll
    for (int qb = 0; qb < 2; ++qb) {
        f32x16 sc = f32x16{};
#pragma unroll
        for (int ds = 0; ds < 4; ++ds) { const bf16x8 qf = *(const LAS bf16x8*)(wl + (qb * 4 + ds) * 1024 + lane * 16); sc = __builtin_amdgcn_mfma_f32_32x32x16_bf16(kf[ds], qf, sc, 0, 0, 0); }
        if (T.mode == 1) {
            const int qr = T.p2 + 2 * qb + (r32 >> 4), c = T.p1 + (r32 & 15); int ks = T.p1 - 8; ks = ks < 0 ? 0 : (ks > 32 ? 32 : ks);
            int win = c - 8; win = win < 0 ? 0 : (win > 48 ? 48 : win); int rsq = qr - 4; rsq = rsq < 0 ? 0 : (rsq > 24 ? 24 : rsq);
            const bool rowok = (unsigned)(T.p0 - rsq) < 8u;
            const int lb = ks + 4 * hi - c + 15, vb = lb - (win - c + 15);
            const LAS float* bp = bias + 48 + (T.p0 - qr + 7) * 31 + lb;
#pragma unroll
            for (int r = 0; r < 16; ++r) { const int cr = (r & 3) + 8 * (r >> 2); const bool ok = rowok && (unsigned)(vb + cr) < 16u; const float bv = bp[cr]; sc[r] = ok ? sc[r] + bv : -INFINITY; }
        } else if (T.mode == 2) { const int base = T.p0 - (32 * qb + r32);
#pragma unroll
            for (int r = 0; r < 16; ++r) { const int d = base + crow(r, hi); if (d > 128 || d < -128) sc[r] = -INFINITY; }
        }
        float tm = sc[0];
#pragma unroll
        for (int r = 1; r < 16; ++r) tm = fmaxf(tm, sc[r]);
        tm = swapmax(tm);
        if (__any(tm > A.m[qb] + 8.f)) {
            const float mn = fmaxf(A.m[qb], tm), al = __builtin_amdgcn_exp2f(A.m[qb] - mn); A.m[qb] = mn; A.l[qb] *= al;
            if (hi == 0) scr[32 * qb + r32] = al;
#pragma unroll
            for (int r = 0; r < 16; ++r) { const float f = scr[32 * qb + crow(r, hi)]; A.o[qb][0][r] *= f; A.o[qb][1][r] *= f; }
        }
        float ps = 0.f; const float mm = A.m[qb];
#pragma unroll
        for (int r = 0; r < 16; ++r) { const float p = __builtin_amdgcn_exp2f(sc[r] - mm); sc[r] = p; ps += p; }
        A.l[qb] += ps;
#pragma unroll
        for (int s2 = 0; s2 < 2; ++s2) { u32x4 w; w.x = cvtpk(sc[8 * s2], sc[8 * s2 + 1]); w.y = cvtpk(sc[8 * s2 + 2], sc[8 * s2 + 3]);
            w.z = cvtpk(sc[8 * s2 + 4], sc[8 * s2 + 5]); w.w = cvtpk(sc[8 * s2 + 6], sc[8 * s2 + 7]); pf[qb][s2] = __builtin_bit_cast(bf16x8, w); }
    }
#pragma unroll
    for (int i = 0; i < 4; ++i) { const int c = lane + 64 * i, key = c >> 3, pc = c & 7; *(LAS u32x4*)(wl + FA_V + (pc >> 2) * 2048 + key * 64 + (pc & 3) * 16) = vr[i]; }
    const LAS char* vb = wl + FA_V + (4 * hi + ((lane & 15) >> 2)) * 64 + (16 * ((lane >> 4) & 1) + 4 * (lane & 3)) * 2;
#pragma unroll
    for (int nb = 0; nb < 2; ++nb)
#pragma unroll
        for (int s2 = 0; s2 < 2; ++s2) { const s16x4 lo = vtr(vb + nb * 2048 + s2 * 1024), hh = vtr(vb + nb * 2048 + s2 * 1024 + 512);
            const bf16x8 vf = {lo[0], lo[1], lo[2], lo[3], hh[0], hh[1], hh[2], hh[3]};
            A.o[0][nb] = __builtin_amdgcn_mfma_f32_32x32x16_bf16(pf[0][s2], vf, A.o[0][nb], 0, 0, 0);
            A.o[1][nb] = __builtin_amdgcn_mfma_f32_32x32x16_bf16(pf[1][s2], vf, A.o[1][nb], 0, 0, 0); }
}
template <class TL, class RM>
__device__ __forceinline__ void fa_unit(const TL& tl, const RM& rm, int nt, const bf16_t* q, int ldq, const bf16_t* kbase, const bf16_t* vbase, int ldkv, bf16_t* out, int ldo, float m0, float l0, LAS char* wl, int lane_in) {
    int lane = lane_in; asm volatile("" : "+v"(lane));
    int r32 = lane & 31, hi = lane >> 5;
#pragma unroll
    for (int qb = 0; qb < 2; ++qb)
#pragma unroll
        for (int ds = 0; ds < 4; ++ds) { const bf16x8 qf = *(const bf16x8*)(q + (size_t)rm(qb, r32) * ldq + 16 * ds + 8 * hi); *(LAS bf16x8*)(wl + (qb * 4 + ds) * 1024 + lane * 16) = qf; }
    FaAcc A;
#pragma unroll
    for (int qb = 0; qb < 2; ++qb) { A.o[qb][0] = f32x16{}; A.o[qb][1] = f32x16{}; A.m[qb] = m0; A.l[qb] = hi == 0 ? l0 : 0.f; }
    FaTile T, Tn; bf16x8 kf[4], kn[4]; u32x4 vr[4];
    tl(0, T); fa_uniform(T); fa_load_k(kbase, T, ldkv, lane, kf);
    for (int t = 0; t < nt; ++t) {
        fa_load_v(vbase, T, ldkv, lane, vr);
        tl(t + 1 < nt ? t + 1 : t, Tn); fa_uniform(Tn); fa_load_k(kbase, Tn, ldkv, lane, kn);
        fa_tile(T, kf, vr, A, wl, lane);
        T = Tn;
#pragma unroll
        for (int i = 0; i < 4; ++i) kf[i] = kn[i];
    }
    asm volatile("" : "+v"(lane)); r32 = lane & 31; hi = lane >> 5;
    LAS float* scr = (LAS float*)(wl + FA_SCR); LAS bf16_t* stg = (LAS bf16_t*)wl;
#pragma unroll
    for (int qb = 0; qb < 2; ++qb) { const float lt = swapsum(A.l[qb]); if (hi == 0) scr[32 * qb + r32] = 1.f / lt; }
    asm volatile("s_waitcnt lgkmcnt(0)" ::: "memory");
#pragma unroll
    for (int qb = 0; qb < 2; ++qb)
#pragma unroll
        for (int r = 0; r < 16; ++r) { const int row = 32 * qb + crow(r, hi); const float f = scr[row];
            stg[row * 64 + r32] = (bf16_t)f2bf(A.o[qb][0][r] * f); stg[row * 64 + 32 + r32] = (bf16_t)f2bf(A.o[qb][1][r] * f); }
    asm volatile("s_waitcnt lgkmcnt(0)" ::: "memory");
#pragma unroll
    for (int it = 0; it < 8; ++it) { const int row = it * 8 + (lane >> 3), ch = lane & 7; const u32x4 v = *(const LAS u32x4*)(wl + row * 128 + ch * 16); *(u32x4*)(out + (size_t)rm(row >> 5, row & 31) * ldo + ch * 8) = v; }
    asm volatile("s_waitcnt lgkmcnt(0)" ::: "memory");
}

struct RowSeq { __device__ __forceinline__ int operator()(int qb, int r32) const { return 32 * qb + r32; } };
struct RowQuad { int c0; __device__ __forceinline__ int operator()(int qb, int r32) const { return (2 * qb + (r32 >> 4)) * 64 + c0 + (r32 & 15); } };
struct NaTiles { unsigned kl, kc; int kr0, nloc, c0, R0;
    __device__ __forceinline__ void operator()(int t, FaTile& T) const {
        if (t < nloc) { int ks = c0 - 8; ks = ks < 0 ? 0 : (ks > 32 ? 32 : ks); T.k = kl + (unsigned)((kr0 + t) * 64 + ks) * ABIN; T.mode = 1; T.p0 = kr0 + t; T.p1 = c0; T.p2 = R0; }
        else { T.k = kc + (unsigned)(32 * (t - nloc)) * ABIN; T.mode = 0; T.p0 = 0; T.p1 = 0; T.p2 = 0; } } };
struct CtxTiles { unsigned kc; int ld;
    __device__ __forceinline__ void operator()(int t, FaTile& T) const { T.k = kc + (unsigned)(32 * t) * ld; T.mode = 0; T.p0 = 0; T.p1 = 0; T.p2 = 0; } };
__device__ __forceinline__ void na_unit(Ctx& F, int u, LAS char* wl) {
    const bf16_t* QKV = (const bf16_t*)(F.ws + WS_QKV); bf16_t* MIX = (bf16_t*)(F.ws + WS_MIX);
    if (u < 4096) { const int j = u & 3, Rq = (u >> 2) & 7, bh = u >> 5, h = bh & 7, b = bh >> 3, R0 = 4 * Rq, c0 = 16 * j;
        LAS float* bias = (LAS float*)(wl + FA_BIAS); const float* rpb = F.in[I_RPB] + (size_t)h * 465;
        for (int i = F.lane; i < 465; i += 64) bias[48 + i] = rpb[i] * LOG2E;
        asm volatile("s_waitcnt lgkmcnt(0)" ::: "memory");
        int kr0 = R0 - 4; kr0 = kr0 < 0 ? 0 : (kr0 > 24 ? 24 : kr0); int rl = R0 + 3 - 4; rl = rl < 0 ? 0 : (rl > 24 ? 24 : rl); const int nloc = rl + 7 - kr0 + 1;
        const size_t rowl = (size_t)b * SEQ, rowc = (size_t)NL + b * CTXL;
        NaTiles tl{(unsigned)(rowl * ABIN + 2560 + h * 64), (unsigned)(rowc * ABIN + 2560 + h * 64), kr0, nloc, c0, R0};
        fa_unit(tl, RowQuad{c0}, nloc + 8, QKV + (rowl + R0 * 64) * ABIN + 2048 + h * 64, ABIN, QKV, QKV + 512, ABIN, MIX + (rowl + R0 * 64) * D + 512 + h * 64, D, -1e30f, 0.f, wl, F.lane);
    } else { const int v = u - 4096, qb = v & 3, bh = v >> 2, h = bh & 7, b = bh >> 3; const size_t rowc = (size_t)NL + b * CTXL;
        CtxTiles tl{(unsigned)(rowc * ABIN + 2560 + h * 64), ABIN};
        fa_unit(tl, RowSeq{}, 8, QKV + (rowc + qb * 64) * ABIN + 2048 + h * 64, ABIN, QKV, QKV + 512, ABIN, MIX + (rowc + qb * 64) * D + 512 + h * 64, D, -1e30f, 0.f, wl, F.lane);
    }
}
struct SwaTiles { unsigned kl, kc; int t0, first, nloc;
    __device__ __forceinline__ void operator()(int t, FaTile& T) const {
        if (t < nloc) { const int ks = first + 32 * t; T.k = kl + (unsigned)ks * SWAIN; const bool inner = (ks >= t0 - 65) && (ks + 31 <= t0 + 128); T.mode = inner ? 0 : 2; T.p0 = ks - t0; T.p1 = 0; T.p2 = 0; }
        else { T.k = kc + (unsigned)(32 * (t - nloc)) * SWAIN; T.mode = 0; T.p0 = 0; T.p1 = 0; T.p2 = 0; } } };
__device__ __forceinline__ void swa_unit(Ctx& F, int u, LAS char* wl) {
    const bf16_t* QKV = (const bf16_t*)(F.ws + WS_QKV); bf16_t* MIX = (bf16_t*)(F.ws + WS_MIX);
    const int g = u & 3, qblk = (u >> 2) & 31, kv = (u >> 7) & 3, b = u >> 9, h = kv * 4 + g, t0 = qblk * 64;
    const size_t rowl = (size_t)b * SEQ, rowc = (size_t)NL + b * CTXL;
    int lo = t0 - 128; lo = lo < 0 ? 0 : lo; int hi = t0 + 192; hi = hi > SEQ ? SEQ : hi;
    SwaTiles tl{(unsigned)(rowl * SWAIN + 1024 + kv * 64), (unsigned)(rowc * SWAIN + 1024 + kv * 64), t0, lo, (hi - lo) >> 5};
    fa_unit(tl, RowSeq{}, tl.nloc + 8, QKV + (rowl + t0) * SWAIN + h * 64, SWAIN, QKV, QKV + 256, SWAIN, MIX + (rowl + t0) * D + h * 64, D, F.in[I_SINK][h] * LOG2E, 1.f, wl, F.lane);
}
__device__ __forceinline__ void phase_na(Ctx& F) {
    LAS char* wl = (LAS char*)F.lds + F.wave * FA_WAVE_LDS;
    unsigned* q = (unsigned*)(F.ws + WS_CTL) + 16;
    for (;;) { unsigned u = 0; if (F.lane == 0) u = atomicAdd(q, 1u); u = __builtin_amdgcn_readfirstlane(u); if (u >= 4096u + 512u) break; na_unit(F, (int)u, wl); }
}
__device__ __forceinline__ void phase_swa(Ctx& F) {
    LAS char* wl = (LAS char*)F.lds + F.wave * FA_WAVE_LDS;
    for (int u = F.blk * NWAVES + F.wave; u < 8192; u += F.nblk * NWAVES) swa_unit(F, u, wl);
}

constexpr size_t WS_SB = WS_Y;
__device__ __forceinline__ bf16x8 trfrag_nat(const LAS char* base) {
    const s16x4 lo = vtr(base), hh = vtr(base + 256); return (bf16x8){lo[0], lo[1], lo[2], lo[3], hh[0], hh[1], hh[2], hh[3]}; }
__device__ __forceinline__ bf16x8 trfrag_acc(const LAS char* base) {
    const s16x4 lo = vtr(base), hh = vtr(base + 512); return (bf16x8){lo[0], lo[1], lo[2], lo[3], hh[0], hh[1], hh[2], hh[3]}; }
__device__ __forceinline__ u32x4 scale8(const u32x4 w, float f) { float t[8]; unpack8(w, t); u32x4 o; o.x = pk2(t[0] * f, t[1] * f); o.y = pk2(t[2] * f, t[3] * f); o.z = pk2(t[4] * f, t[5] * f); o.w = pk2(t[6] * f, t[7] * f); return o; }

__device__ __forceinline__ void ret_unit(Ctx& F, int bh) {
    const int b = bh >> 3, h = bh & 7;
    int lane = F.lane; asm volatile("" : "+v"(lane));
    const int wave = F.wave, r32 = lane & 31, hi = lane >> 5, grp = wave >> 2, wq = wave & 3, t4 = (wave & 3) * 64 + lane;
    const float lgf = log1pf(-exp2f(-F.in[I_RETDEC][h])) * LOG2E, lgb = log1pf(-exp2f(-F.in[I_RETDEC][8 + h])) * LOG2E;
    const bf16_t* QKV = (const bf16_t*)(F.ws + WS_QKV); bf16_t* MIX = (bf16_t*)(F.ws + WS_MIX);
    const size_t rowl = (size_t)b * SEQ, rowc = (size_t)NL + b * CTXL;
    bf16_t* SB = (bf16_t*)(F.ws + WS_SB) + (size_t)bh * 2 * 18 * 4096;
    LAS char* L = (LAS char*)F.lds;
    const int trq = (lane & 15) >> 2, trp = lane & 3, trg = (lane >> 4) & 1;
    const int troff = trq * 64 + (16 * trg + 4 * trp) * 2;
    LAS float* gnl = (LAS float*)(L + 135168);
    if (F.tid < 64) gnl[F.tid] = F.in[I_RETGN][h * 64 + F.tid];
    {
        LAS char* Kd = L + grp * 32768; LAS char* Vt = Kd + 16384;
        const float lg = grp ? lgb : lgf, g128 = __builtin_amdgcn_exp2f(lg * 128.f);
        const int dkb = wq >> 1, dvb = wq & 1;
        f32x16 st = f32x16{};
        for (int i = 0; i < 18; ++i) {
            const int seq = grp ? (i < 2 ? 1 - i : 19 - i) : i;
            { bf16_t* sp = SB + (size_t)(grp * 18 + seq) * 4096;
#pragma unroll
              for (int r = 0; r < 16; ++r) sp[(32 * dkb + crow(r, hi)) * 64 + 32 * dvb + r32] = (bf16_t)f2bf(st[r]); }
            if (i == 17) break;
            const size_t row0 = seq < 2 ? rowc + 128 * seq : rowl + 128 * (seq - 2);
#pragma unroll
            for (int j = 0; j < 4; ++j) { const int p = t4 + 256 * j, row = p >> 3, pc = p & 7;
                const u32x4 kv = *(const u32x4*)(QKV + (row0 + row) * ABIN + 512 + h * 64 + pc * 8), vv = *(const u32x4*)(QKV + (row0 + row) * ABIN + 1024 + h * 64 + pc * 8);
                const float dec = __builtin_amdgcn_exp2f(lg * (float)(grp ? row : 127 - row));
                const int off = (pc >> 2) * 8192 + row * 64 + (pc & 3) * 16;
                *(LAS u32x4*)(Kd + off) = scale8(kv, dec); *(LAS u32x4*)(Vt + off) = vv; }
            asm volatile("s_waitcnt lgkmcnt(0)" ::: "memory"); __syncthreads();
#pragma unroll
            for (int r = 0; r < 16; ++r) st[r] *= g128;
#pragma unroll
            for (int s2 = 0; s2 < 8; ++s2) { const int ro = (16 * s2 + 8 * hi) * 64 + troff;
                const bf16x8 af = trfrag_nat(Kd + dkb * 8192 + ro), bf = trfrag_nat(Vt + dvb * 8192 + ro);
                st = __builtin_amdgcn_mfma_f32_32x32x16_bf16(af, bf, st, 0, 0, 0); }
            asm volatile("s_waitcnt lgkmcnt(0)" ::: "memory"); __syncthreads();
        }
    }
    asm volatile("s_waitcnt vmcnt(0)" ::: "memory"); __syncthreads();
    for (int rd = 0; rd < 9; ++rd) {
        const int seq = 2 * rd + grp;
        const size_t row0 = seq < 2 ? rowc + 128 * seq : rowl + 128 * (seq - 2);
        LAS char* Vt = L + grp * 16384; LAS char* Sf = L + 32768 + grp * 16384; LAS char* Sbk = Sf + 8192;
#pragma unroll
        for (int j = 0; j < 4; ++j) { const int p = t4 + 256 * j, row = p >> 3, pc = p & 7;
            *(LAS u32x4*)(Vt + (pc >> 2) * 8192 + row * 64 + (pc & 3) * 16) = *(const u32x4*)(QKV + (row0 + row) * ABIN + 1024 + h * 64 + pc * 8); }
#pragma unroll
        for (int j = 0; j < 4; ++j) { const int p = t4 + 256 * j, d = j >> 1, pp = p & 511, row = pp >> 3, pc = pp & 7;
            *(LAS u32x4*)((d ? Sbk : Sf) + (pc >> 2) * 4096 + row * 64 + (pc & 3) * 16) = *(const u32x4*)(SB + (size_t)(d * 18 + seq) * 4096 + row * 64 + pc * 8); }
        bf16x8 qf[4], kfa[4][4];
#pragma unroll
        for (int ds = 0; ds < 4; ++ds) qf[ds] = *(const bf16x8*)(QKV + (row0 + 32 * wq + r32) * ABIN + h * 64 + 16 * ds + 8 * hi);
#pragma unroll
        for (int kb = 0; kb < 4; ++kb)
#pragma unroll
            for (int ds = 0; ds < 4; ++ds) kfa[kb][ds] = *(const bf16x8*)(QKV + (row0 + 32 * kb + r32) * ABIN + 512 + h * 64 + 16 * ds + 8 * hi);
        asm volatile("s_waitcnt lgkmcnt(0)" ::: "memory"); __syncthreads();
        f32x16 oi[2], of[2], ob[2];
#pragma unroll
        for (int nb = 0; nb < 2; ++nb) { oi[nb] = f32x16{}; of[nb] = f32x16{}; ob[nb] = f32x16{}; }
        const int nq = 32 * wq + r32;
#pragma unroll
        for (int kb = 0; kb < 4; ++kb) {
            f32x16 sc = f32x16{};
#pragma unroll
            for (int ds = 0; ds < 4; ++ds) sc = __builtin_amdgcn_mfma_f32_32x32x16_bf16(kfa[kb][ds], qf[ds], sc, 0, 0, 0);
#pragma unroll
            for (int r = 0; r < 16; ++r) { const int d = nq - (32 * kb + crow(r, hi)); const float e = __builtin_amdgcn_exp2f((d > 0 ? lgf : -lgb) * (float)d); sc[r] *= (d == 0 ? 2.f : e); }
#pragma unroll
            for (int s2 = 0; s2 < 2; ++s2) { u32x4 w; w.x = cvtpk(sc[8 * s2], sc[8 * s2 + 1]); w.y = cvtpk(sc[8 * s2 + 2], sc[8 * s2 + 3]); w.z = cvtpk(sc[8 * s2 + 4], sc[8 * s2 + 5]); w.w = cvtpk(sc[8 * s2 + 6], sc[8 * s2 + 7]);
                const bf16x8 pf = __builtin_bit_cast(bf16x8, w);
#pragma unroll
                for (int nb = 0; nb < 2; ++nb) { const bf16x8 vf = trfrag_acc(Vt + nb * 8192 + (32 * kb + 16 * s2 + 4 * hi) * 64 + troff);
                    oi[nb] = __builtin_amdgcn_mfma_f32_32x32x16_bf16(pf, vf, oi[nb], 0, 0, 0); } }
        }
#pragma unroll
        for (int nb = 0; nb < 2; ++nb)
#pragma unroll
            for (int s2 = 0; s2 < 4; ++s2) { const int ro = nb * 4096 + (16 * s2 + 8 * hi) * 64 + troff;
                of[nb] = __builtin_amdgcn_mfma_f32_32x32x16_bf16(qf[s2], trfrag_nat(Sf + ro), of[nb], 0, 0, 0);
                ob[nb] = __builtin_amdgcn_mfma_f32_32x32x16_bf16(qf[s2], trfrag_nat(Sbk + ro), ob[nb], 0, 0, 0); }
        LAS float* stg = (LAS float*)(L + 65536 + wave * 8704);
#pragma unroll
        for (int r = 0; r < 16; ++r) { const int n = 32 * wq + crow(r, hi); const float sf = __builtin_amdgcn_exp2f(lgf * (float)(n + 1)), sb = __builtin_amdgcn_exp2f(lgb * (float)(128 - n));
            stg[crow(r, hi) * 68 + r32] = oi[0][r] + sf * of[0][r] + sb * ob[0][r]; stg[crow(r, hi) * 68 + 32 + r32] = oi[1][r] + sf * of[1][r] + sb * ob[1][r]; }
        asm volatile("s_waitcnt lgkmcnt(0)" ::: "memory");
        { float v[32]; float sm = 0.f;
#pragma unroll
          for (int c4 = 0; c4 < 8; ++c4) { const f32x4 t = *(const LAS f32x4*)(stg + r32 * 68 + 32 * hi + 4 * c4); v[4 * c4] = t[0]; v[4 * c4 + 1] = t[1]; v[4 * c4 + 2] = t[2]; v[4 * c4 + 3] = t[3]; sm += (t[0] + t[1]) + (t[2] + t[3]); }
          const float mu = swapsum(sm) * (1.f / 64.f); float vs = 0.f;
#pragma unroll
          for (int i = 0; i < 32; ++i) { v[i] -= mu; vs += v[i] * v[i]; }
          const float rs = rsqrtf(swapsum(vs) * (1.f / 64.f) + 1e-5f);
          const size_t row = row0 + 32 * wq + r32; const bf16_t* gp = QKV + row * ABIN + 1536 + h * 64 + 32 * hi; const LAS float* gn = gnl + 32 * hi; bf16_t* op = MIX + row * D + h * 64 + 32 * hi;
          u32x4 gw4[4];
#pragma unroll
          for (int c8 = 0; c8 < 4; ++c8) gw4[c8] = __builtin_nontemporal_load((const u32x4*)(gp + 8 * c8));
#pragma unroll
          for (int c8 = 0; c8 < 4; ++c8) { float g[8], t[8]; unpack8(gw4[c8], g);
#pragma unroll
              for (int i = 0; i < 8; ++i) t[i] = v[8 * c8 + i] * rs * gn[8 * c8 + i] * g[i] * __builtin_amdgcn_rcpf(1.f + __builtin_amdgcn_exp2f(-LOG2E * g[i]));
              store8_bf16(op + 8 * c8, t); } }
        asm volatile("s_waitcnt lgkmcnt(0)" ::: "memory"); __syncthreads();
    }
}
__device__ __forceinline__ void phase_ret(Ctx& F) {
    if (F.blk < 128) ret_unit(F, F.blk);
    __syncthreads();
}

#define XB_TMO      128
#define XB_XCNT(j)  (256  + 64 * (j))
#define XB_XSUB(j)  (1280 + 64 * (j))
#define XB_XGEN(j)  (2304 + 64 * (j))
#define XB_TOP      3328
#define XB_TOPGEN   3392
#define XCD_BAR_WORDS 3456
#define XB_SPIN_CAP (1u << 18)

__device__ __forceinline__ unsigned xb_ld(unsigned* p)              { return __hip_atomic_load(p, __ATOMIC_RELAXED, __HIP_MEMORY_SCOPE_AGENT); }
__device__ __forceinline__ unsigned xb_add(unsigned* p, unsigned v) { return __hip_atomic_fetch_add(p, v, __ATOMIC_RELAXED, __HIP_MEMORY_SCOPE_AGENT); }
__device__ __forceinline__ unsigned xb_xcc_id() { return (unsigned)__builtin_amdgcn_s_getreg((3 << 11) | 20) & 0xFu; }
#define XB_SPIN(cond, bar) do { unsigned _sp = 0; while (cond) { __builtin_amdgcn_s_sleep(1); \
    if ((++_sp & 255u) == 0u) { if (xb_ld(&(bar)[XB_TMO])) break; if (_sp > XB_SPIN_CAP) { atomicAdd(&(bar)[XB_TMO], 1u); break; } } } } while (0)

struct XcdBarrier {
    unsigned* bar; unsigned x;
    volatile LAS unsigned* st;
};

__device__ __forceinline__ XcdBarrier xcd_barrier_post(unsigned* bar, volatile LAS unsigned* st) {
    XcdBarrier b; b.bar = bar; b.x = xb_xcc_id(); b.st = st;
    if (threadIdx.x == 0) (void)xb_add(&bar[XB_XCNT(b.x)], 1u);
    return b;
}
__device__ __forceinline__ void xcd_barrier_complete(unsigned* bar, unsigned x, unsigned& nloc, unsigned& nx) {
    const unsigned G = gridDim.x * gridDim.y * gridDim.z;
    unsigned sum, cnt, mine, sp = 0u;
    for (;;) {
        sum = 0u; cnt = 0u; mine = 0u;
#pragma unroll
        for (unsigned j = 0; j < 16; ++j) { const unsigned c = xb_ld(&bar[XB_XCNT(j)]); sum += c; cnt += (c > 0u) ? 1u : 0u; mine = (j == x) ? c : mine; }
        if (sum == G) break;
        __builtin_amdgcn_s_sleep(1);
        if ((++sp & 255u) == 0u) { if (xb_ld(&bar[XB_TMO])) break; if (sp > XB_SPIN_CAP) { atomicAdd(&bar[XB_TMO], 1u); break; } }
    }
    nloc = mine > 0u ? mine : 1u; nx = cnt > 0u ? cnt : 1u;
}

__device__ __forceinline__ void xcd_barrier(const XcdBarrier& b, const bool leader) {
    asm volatile("s_waitcnt vmcnt(0)" ::: "memory");
    __syncthreads();
    if (leader) {
        unsigned* bar = b.bar;
        __builtin_amdgcn_s_waitcnt(0);
        unsigned nloc = b.st[0], nx = b.st[1];
        if (nloc == 0u) { xcd_barrier_complete(bar, b.x, nloc, nx); b.st[0] = nloc; b.st[1] = nx; }
        const unsigned old = xb_add(&bar[XB_XSUB(b.x)], 1u);
        const unsigned gen = old / nloc;
        if (old + 1u == (gen + 1u) * nloc) {
            __builtin_amdgcn_fence(__ATOMIC_RELEASE, "agent");
            asm volatile("s_waitcnt vmcnt(0)" ::: "memory");
            const unsigned og = xb_add(&bar[XB_TOP], 1u);
            const unsigned tg = og / nx;
            if (og + 1u == (tg + 1u) * nx) xb_add(&bar[XB_TOPGEN], 1u);
            else XB_SPIN(xb_ld(&bar[XB_TOPGEN]) == tg, bar);
            __builtin_amdgcn_fence(__ATOMIC_ACQUIRE, "agent");
            xb_add(&bar[XB_XGEN(b.x)], 1u);
            asm volatile("s_waitcnt vmcnt(0)" ::: "memory");
        } else {
            XB_SPIN(xb_ld(&bar[XB_XGEN(b.x)]) == gen, bar);
            __builtin_amdgcn_fence(__ATOMIC_ACQUIRE, "agent");
            asm volatile("s_waitcnt vmcnt(0)" ::: "memory");
        }
    }
    __syncthreads();
}

constexpr int LDS_BYTES = 150 * 1024;
constexpr int NPHASE = 18;
__global__ void __launch_bounds__(NTHREADS, 2) fwd_kernel(Args args) {
    extern __shared__ __attribute__((aligned(16))) unsigned char lds_raw[];
    Ctx F;
#pragma unroll
    for (int i = 0; i < 22; ++i) F.in[i] = args.in[i];
    F.out = args.out; F.ws = args.ws; F.lds = (LAS unsigned char*)lds_raw;
    F.tid = threadIdx.x; F.lane = F.tid & 63; F.wave = __builtin_amdgcn_readfirstlane(F.tid >> 6); F.blk = blockIdx.x; F.nblk = gridDim.x;
    const float* mod = (const float*)(F.ws + WS_MOD); const float* rt = (const float*)(F.ws + WS_ROPE);
    const int* tile_e = (const int*)(F.ws + WS_ROUTE + RT_TILEE);
    cg::grid_group grid = cg::this_grid();
    const int lo = args.ph_lo, hi = args.ph_hi;
    volatile LAS unsigned* bst = (volatile LAS unsigned*)(F.lds + LDS_BYTES - 16);
    if (F.tid < 4) bst[F.tid] = 0u;
    __syncthreads();
    XcdBarrier bar = xcd_barrier_post((unsigned*)(F.ws + WS_CTL) + 1024, bst);
    if (hi > NPHASE) grid.sync();
#ifndef REPEAT_MASK
#define REPEAT_MASK 0
#endif
#define PH(k) asm volatile("v_mbcnt_lo_u32_b32 %0, -1, 0\n\tv_mbcnt_hi_u32_b32 %0, -1, %0" : "=v"(F.lane)); F.tid = F.wave * 64 + F.lane; if (lo <= (k) && (k) < hi)
#define SEAM(k) do { if ((k) + 1 < hi) xcd_barrier(bar, F.tid == 0); } while (0)
    PH(0) { phase_prep(F); }
    PH(1) { wait_mod(F); phase_cvec(F); phase_norm0(F); SEAM(1); }
    PH(2) { { GemmDesc g{(const bf16_t*)(F.ws + WS_H), D, (const bf16_t*)(F.ws + WS_WIN0), D, NTOK / 256, ABIN / 256, nullptr, 0};
                  gemm_run(F, g, EpiIn0{(bf16_t*)(F.ws + WS_QKV), rt}); } SEAM(2); }
    PH(3) { phase_ret(F); asm volatile("v_mbcnt_lo_u32_b32 %0, -1, 0\n\tv_mbcnt_hi_u32_b32 %0, -1, %0" : "=v"(F.lane)); F.tid = F.wave * 64 + F.lane; phase_na(F); SEAM(3); }
    PH(4) { { GemmDesc g{(const bf16_t*)(F.ws + WS_MIX), D, (const bf16_t*)(F.ws + WS_WOUT0), D, NTOK / 256, 4, nullptr, 0};
                  gemm_run(F, g, EpiResT<true>{F.in[I_X], F.in[I_CTX], (bf16_t*)(F.ws + WS_XB), mod});  conv_tail(F, 64, 0); } SEAM(4); }
    PH(5) { phase_router(F, 0, NTOK); SEAM(5); }
    PH(6) { phase_slots(F, 0, NTOK); SEAM(6); }
    PH(7) { { GemmDesc g{(const bf16_t*)(F.ws + WS_H), D, (const bf16_t*)(F.ws + WS_WGU), D, tile_e[320], 4, tile_e, (size_t)1024 * 1024, (const int*)(F.ws + WS_STOK)};
                  gemm_run(F, g, EpiGU{(bf16_t*)(F.ws + WS_ACT)}); } SEAM(7); }
    PH(8) { { GemmDesc g{(const bf16_t*)(F.ws + WS_ACT), FF, (const bf16_t*)(F.ws + WS_WDN), FF, tile_e[320], 4, tile_e, (size_t)1024 * 512};
                  gemm_run(F, g, EpiY{(bf16_t*)(F.ws + WS_Y)}); } SEAM(8); }
    PH(9) { phase_combine(F, 0); SEAM(9); }
    PH(10) { { GemmDesc g{(const bf16_t*)(F.ws + WS_H), D, (const bf16_t*)(F.ws + WS_WIN1), D, NL / 256, 6, nullptr, 0};
                   gemm_run(F, g, EpiIn1{(bf16_t*)(F.ws + WS_QKV), rt, 0, 0});
                   GemmDesc g2{(const bf16_t*)(F.ws + WS_H) + (size_t)NL * D, D, (const bf16_t*)(F.ws + WS_WIN1) + (size_t)1024 * D, D, NC / 256, 2, nullptr, 0};
                   gemm_run(F, g2, EpiIn1{(bf16_t*)(F.ws + WS_QKV), rt, 1024, NL});  conv_tail(F, 32, 6144); } SEAM(10); }
    PH(11) { phase_swa(F); SEAM(11); }
    PH(12) { { GemmDesc g{(const bf16_t*)(F.ws + WS_MIX), D, (const bf16_t*)(F.ws + WS_WOUT1), D, NL / 256, 4, nullptr, 0};
                   gemm_run(F, g, EpiResT<false>{nullptr, nullptr, (bf16_t*)(F.ws + WS_XB), mod + 17 * 6144}); } SEAM(12); }
    PH(13) { phase_router(F, 1, NL); SEAM(13); }
    PH(14) { phase_slots(F, 1, NL); SEAM(14); }
    PH(15) { { GemmDesc g{(const bf16_t*)(F.ws + WS_H), D, (const bf16_t*)(F.ws + WS_WGU) + (size_t)32 * 1024 * 1024, D, tile_e[320], 4, tile_e, (size_t)1024 * 1024, (const int*)(F.ws + WS_STOK)};
                   gemm_run(F, g, EpiGU{(bf16_t*)(F.ws + WS_ACT)}); } SEAM(15); }
    PH(16) { { GemmDesc g{(const bf16_t*)(F.ws + WS_ACT), FF, (const bf16_t*)(F.ws + WS_WDN) + (size_t)32 * 1024 * 512, FF, tile_e[320], 4, tile_e, (size_t)1024 * 512};
                   gemm_run(F, g, EpiY{(bf16_t*)(F.ws + WS_Y)}); } SEAM(16); }
    PH(17) { phase_combine(F, 1); SEAM(17); }
#undef PH
#undef SEAM
}

extern "C" void kernel_launch(void* const* d_in, const int* in_sizes, int n_in, void* d_out, int out_size, void* d_ws, size_t ws_size, hipStream_t stream) {
    static int ready = 0, grid_blocks = 0;
    if (!ready) {
        if (n_in != 22 || out_size != NL * D || ws_size < WS_END) { fprintf(stderr, "kernel_launch: unexpected shapes (n_in %d out %d ws %zu)\n", n_in, out_size, ws_size); ready = -1; return; }
        if (hipFuncSetAttribute((const void*)fwd_kernel, hipFuncAttributeMaxDynamicSharedMemorySize, LDS_BYTES) != hipSuccess) { fprintf(stderr, "kernel_launch: hipFuncSetAttribute failed\n"); ready = -1; return; }
        int dev = 0, cus = 0, per_cu = 0;
        (void)hipGetDevice(&dev); (void)hipDeviceGetAttribute(&cus, hipDeviceAttributeMultiprocessorCount, dev);
        if (hipOccupancyMaxActiveBlocksPerMultiprocessor(&per_cu, (const void*)fwd_kernel, NTHREADS, LDS_BYTES) != hipSuccess || per_cu < 1) { fprintf(stderr, "kernel_launch: occupancy query failed (%d)\n", per_cu); ready = -1; return; }
        if (cus * per_cu < 256) { fprintf(stderr, "kernel_launch: needs 256 co-resident workgroups, device admits %d x %d\n", cus, per_cu); ready = -1; return; }
        grid_blocks = 256;
        ready = 1;
    }
    if (ready < 0) return;
    Args a{};
    for (int i = 0; i < 22; ++i) a.in[i] = (const float*)d_in[i];
    a.out = (float*)d_out; a.ws = (unsigned char*)d_ws;
    a.ph_lo = 0; a.ph_hi = NPHASE;
    if (hipMemsetAsync((char*)d_ws + WS_CTL, 0, 65536, stream) != hipSuccess) { fprintf(stderr, "kernel_launch: memset failed\n"); return; }
    void* kargs[] = {&a};
    hipError_t e = hipLaunchCooperativeKernel((const void*)fwd_kernel, dim3(grid_blocks), dim3(NTHREADS), kargs, LDS_BYTES, stream);
    if (e != hipSuccess) fprintf(stderr, "cooperative launch failed: %s (grid %d)\n", hipGetErrorString(e), grid_blocks);
}
```

```cpp
#include <hip/hip_runtime.h>
#include <hip/hip_cooperative_groups.h>
namespace cg = cooperative_groups;
#include <cstdio>
#include <cstdint>

#define LAS __attribute__((address_space(3)))
typedef unsigned short bf16_t;
typedef float f32x4 __attribute__((ext_vector_type(4)));
typedef unsigned u32x4 __attribute__((ext_vector_type(4)));
typedef unsigned u32x2 __attribute__((ext_vector_type(2)));
typedef short bf16x8 __attribute__((ext_vector_type(8)));

constexpr int D = 1024, NB = 16, SEQ = 2048, CTXL = 256, GW = 64;
constexpr int NL = NB * SEQ, NC = NB * CTXL, NTOK = NL + NC;
constexpr int ABIN = 3584, SWAIN = 1536, FF = 512, NEXP = 32;
constexpr int NTHREADS = 512, NWAVES = 8;
constexpr int MAXSLOT = 81920;
constexpr float LOG2E = 1.4426950408889634f;

constexpr size_t MiB = 1u << 20;
constexpr size_t WS_CTL = 0;
constexpr size_t WS_MOD = 1 * MiB;
constexpr size_t WS_ROPE = 2 * MiB;
constexpr size_t WS_RW = 2 * MiB + 16384;
constexpr size_t WS_ROUTE = 2 * MiB + 16384 + 393216;
constexpr size_t WS_WIN0 = 4 * MiB;
constexpr size_t WS_WOUT0 = 12 * MiB;
constexpr size_t WS_WIN1 = 14 * MiB;
constexpr size_t WS_WOUT1 = 18 * MiB;
constexpr size_t WS_WGU = 20 * MiB;
constexpr size_t WS_WDN = 148 * MiB;
constexpr size_t WS_STOK = 212 * MiB;
constexpr size_t WS_XC = 212 * MiB;
constexpr size_t WS_H = 228 * MiB;
constexpr size_t WS_MIX = 300 * MiB;
constexpr size_t WS_QKV = 372 * MiB;
constexpr size_t WS_HS = WS_QKV;
constexpr size_t WS_ACT = WS_QKV + 160 * MiB;
constexpr size_t WS_Y = 624 * MiB;
constexpr size_t WS_XB = 784 * MiB;
constexpr size_t WS_END = 856 * MiB;
constexpr size_t RT_TOKE = 0;
constexpr size_t RT_TOKW = RT_TOKE + (size_t)NTOK * 8;
constexpr size_t RT_TOKR = RT_TOKW + (size_t)NTOK * 8;
constexpr size_t RT_TOKS = RT_TOKR + (size_t)NTOK * 8;
constexpr size_t RT_BCNT = RT_TOKS + (size_t)NTOK * 8;
constexpr size_t RT_TILEE = RT_BCNT + 256 * 32 * 4;
constexpr size_t RT_CVEC = RT_TILEE + 324 * 4 + 16;
constexpr size_t RT_RSTD = RT_CVEC + 2 * 17 * 48 * 4;
constexpr size_t RT_END = RT_RSTD + (size_t)NTOK * 4;
static_assert(WS_ROUTE + RT_END <= WS_WIN0, "route arrays");

__device__ __forceinline__ float bf2f(unsigned v) { return __uint_as_float(v << 16); }
__device__ __forceinline__ unsigned f2bf(float f) { unsigned u = __float_as_uint(f); return (u + 0x7fffu + ((u >> 16) & 1u)) >> 16; }
__device__ __forceinline__ unsigned pk2(float lo, float hi) { typedef float f2_t __attribute__((ext_vector_type(2))); typedef __bf16 b2_t __attribute__((ext_vector_type(2)));
    f2_t v = {lo, hi}; b2_t b = __builtin_convertvector(v, b2_t); return __builtin_bit_cast(unsigned, b); }
__device__ __forceinline__ void store8_bf16(bf16_t* p, const float* v) { u32x4 w; w.x = pk2(v[0], v[1]); w.y = pk2(v[2], v[3]); w.z = pk2(v[4], v[5]); w.w = pk2(v[6], v[7]); *(u32x4*)p = w; }
__device__ __forceinline__ unsigned pk4_fp8(float a, float b, float c, float d) { int w = __builtin_amdgcn_cvt_pk_fp8_f32(a, b, 0, false); w = __builtin_amdgcn_cvt_pk_fp8_f32(c, d, w, true); return (unsigned)w; }
constexpr float A8_SCALE = 8.f, W8_SCALE = 64.f, H8_SCALE = 16.f;
__device__ __forceinline__ float wave_sum(float v) {
#pragma unroll
    for (int o = 1; o < 64; o <<= 1) v += __shfl_xor(v, o);
    return v;
}
__device__ __forceinline__ float silu_f(float v) { return v / (1.f + __expf(-v)); }
__device__ __forceinline__ void unpack8(const u32x4 w, float* f) {
    f[0] = bf2f(w.x & 0xffffu); f[1] = bf2f(w.x >> 16); f[2] = bf2f(w.y & 0xffffu); f[3] = bf2f(w.y >> 16);
    f[4] = bf2f(w.z & 0xffffu); f[5] = bf2f(w.z >> 16); f[6] = bf2f(w.w & 0xffffu); f[7] = bf2f(w.w >> 16);
}

struct Args { const float* in[22]; float* out; unsigned char* ws; int ph_lo, ph_hi; };
enum { I_X = 0, I_C, I_CTX, I_CCTX, I_ADAW, I_ADAB, I_NORMG, I_FINALG, I_ABWIN, I_ABWOUT, I_RETDEC, I_RETGN, I_RPB, I_SWAWIN, I_SWAWOUT, I_SINK,
       I_RGW, I_RGB, I_REW, I_REB, I_WGU, I_WDN };

struct Ctx {
    const float* in[22]; float* out; unsigned char* ws;
    LAS unsigned char* lds;
    int tid, lane, wave, blk, nblk;
};

template <class DMap>
__device__ __forceinline__ void transpose_item(const float* W, int K, int N, bf16_t* WT, int k0, int n0, const DMap& dmap, LAS float* scr, int lane) {
    const int c4 = lane & 15, kr = lane >> 4;
#pragma unroll
    for (int i = 0; i < 16; ++i) { const int kk = 4 * i + kr; *(LAS f32x4*)(scr + kk * 68 + 4 * c4) = __builtin_nontemporal_load((const f32x4*)(W + (size_t)(k0 + kk) * N + n0 + 4 * c4)); }
    asm volatile("s_waitcnt lgkmcnt(0)" ::: "memory");
    const int c = lane & 7;
#pragma unroll
    for (int j = 0; j < 8; ++j) { const int n = (lane >> 3) + 8 * j; const LAS float* sp = scr + (8 * c) * 68 + n;
        u32x4 o; o.x = pk2(sp[0 * 68], sp[1 * 68]); o.y = pk2(sp[2 * 68], sp[3 * 68]); o.z = pk2(sp[4 * 68], sp[5 * 68]); o.w = pk2(sp[6 * 68], sp[7 * 68]);
        __builtin_nontemporal_store(o, (u32x4*)(WT + (size_t)dmap(n0 + n) * K + k0 + 8 * c)); }
    asm volatile("s_waitcnt lgkmcnt(0)" ::: "memory");
}
template <class DMap>
__device__ __forceinline__ void transpose_item8(const float* W, int K, int N, unsigned char* WT, int k0, int n0, const DMap& dmap, LAS float* scr, int lane) {
    const int c4 = lane & 15, kr = lane >> 4;
#pragma unroll
    for (int i = 0; i < 16; ++i) { const int kk = 4 * i + kr; *(LAS f32x4*)(scr + kk * 68 + 4 * c4) = __builtin_nontemporal_load((const f32x4*)(W + (size_t)(k0 + kk) * N + n0 + 4 * c4)); }
    asm volatile("s_waitcnt lgkmcnt(0)" ::: "memory");
    const int c = lane & 7;
#pragma unroll
    for (int j = 0; j < 8; ++j) { const int n = (lane >> 3) + 8 * j; const LAS float* sp = scr + (8 * c) * 68 + n;
        u32x2 o; o.x = pk4_fp8(W8_SCALE * sp[0 * 68], W8_SCALE * sp[1 * 68], W8_SCALE * sp[2 * 68], W8_SCALE * sp[3 * 68]); o.y = pk4_fp8(W8_SCALE * sp[4 * 68], W8_SCALE * sp[5 * 68], W8_SCALE * sp[6 * 68], W8_SCALE * sp[7 * 68]);
        __builtin_nontemporal_store(o, (u32x2*)(WT + (size_t)dmap(n0 + n) * K + k0 + 8 * c)); }
    asm volatile("s_waitcnt lgkmcnt(0)" ::: "memory");
}
struct DMapId { __device__ __forceinline__ int operator()(int n) const { return n; } };
__device__ __forceinline__ int gu_row(int n) { const int u = n >= 512, g = n & 511; return 256 * (g >> 7) + 128 * u + (g & 127); }
struct DMapGU { __device__ __forceinline__ int operator()(int n) const { return gu_row(n); } };

__device__ __forceinline__ void phase_prep(Ctx& F) {
    if (F.blk < 192) {
        const int l = F.blk / 96, col0 = (F.blk % 96) * 64;
        LAS float* s = (LAS float*)F.lds;
        LAS float* red = (LAS float*)(F.lds + 17 * 1024 * 4);
        for (int idx = F.tid; idx < 17 * 1024; idx += NTHREADS) { const int r = idx >> 10, k = idx & 1023; const float v = r < 16 ? F.in[I_C][r * 1024 + k] : F.in[I_CCTX][k]; s[idx] = silu_f(v); }
        __syncthreads();
        float acc[17];
#pragma unroll
        for (int r = 0; r < 17; ++r) acc[r] = 0.f;
        const float* wp = F.in[I_ADAW] + ((size_t)l * 1024 + F.wave * 128) * 6144 + col0 + F.lane;
        for (int k0 = 0; k0 < 128; k0 += 16) { float wv[16];
#pragma unroll
            for (int j = 0; j < 16; ++j) wv[j] = __builtin_nontemporal_load(wp + (size_t)(k0 + j) * 6144);
#pragma unroll
            for (int j = 0; j < 16; ++j)
#pragma unroll
                for (int r = 0; r < 17; ++r) acc[r] += s[r * 1024 + F.wave * 128 + k0 + j] * wv[j]; }
#pragma unroll
        for (int r = 0; r < 17; ++r) red[(F.wave * 17 + r) * 64 + F.lane] = acc[r];
        __syncthreads();
        float* mod = (float*)(F.ws + WS_MOD);
        for (int idx = F.tid; idx < 17 * 64; idx += NTHREADS) { const int r = idx >> 6, cl = idx & 63; float v = F.in[I_ADAB][l * 6144 + col0 + cl];
#pragma unroll
            for (int w = 0; w < 8; ++w) v += red[(w * 17 + r) * 64 + cl];
            mod[(size_t)(l * 17 + r) * 6144 + col0 + cl] = v; }
        asm volatile("s_waitcnt vmcnt(0)" ::: "memory");
        __syncthreads();
        if (F.tid == 0) { __builtin_amdgcn_fence(__ATOMIC_RELEASE, "agent"); asm volatile("s_waitcnt vmcnt(0)" ::: "memory");
            __hip_atomic_fetch_add((unsigned*)(F.ws + WS_CTL) + 400, 1u, __ATOMIC_RELAXED, __HIP_MEMORY_SCOPE_AGENT); }
    }
    if (F.blk == F.nblk - 1) {
        float* rt = (float*)(F.ws + WS_ROPE);
        for (int idx = F.tid; idx < 1024; idx += NTHREADS) { const int pos = idx >> 4, f = idx & 15;
            const float inv = exp2f(-(float)f * (13.287712379549449f / 16.f));
            const float ang = (float)pos * inv; const double rev = (double)ang * 0.15915494309189535; const float fr = (float)(rev - floor(rev));
            rt[idx * 2] = __builtin_amdgcn_cosf(fr); rt[idx * 2 + 1] = __builtin_amdgcn_sinf(fr); }
    }
    if (F.blk == F.nblk - 2) {
        bf16_t* rw = (bf16_t*)(F.ws + WS_RW);
        for (int idx = F.tid; idx < 2 * 48 * 1024; idx += NTHREADS) { const int l = idx / 49152, rem = idx % 49152, c = rem >> 10, k = rem & 1023;
            const float w = c < 4 ? F.in[I_RGW][(size_t)(l * 1024 + k) * 4 + c] : (c < 36 ? F.in[I_REW][(size_t)(l * 1024 + k) * 32 + c - 4] : 0.f);
            const unsigned h = f2bf(w); const float r = w - bf2f(h);
            rw[(size_t)(l * 2) * 49152 + rem] = (bf16_t)h; rw[(size_t)(l * 2 + 1) * 49152 + rem] = (bf16_t)f2bf(r); }
    }
    __syncthreads();
    LAS float* scr = (LAS float*)(F.lds + F.wave * 17408);
    const int gw = F.blk * NWAVES + F.wave, NGW = F.nblk * NWAVES;
    constexpr int I0 = 16 * 56, I1 = 16 * 16, I2 = 16 * 24, I3 = 16 * 16, I4 = 32 * 16 * 16, I5 = 32 * 8 * 16;
    unsigned* q = (unsigned*)(F.ws + WS_CTL) + 208; LAS unsigned* qb = (LAS unsigned*)(F.lds + 139264 + 64);
    for (;;) {
        __syncthreads();
        if (F.tid == 0) *qb = atomicAdd(q, 8u);
        __syncthreads();
        const unsigned base = *qb; if (base >= (unsigned)(I0 + I1 + I2 + I3 + I4 + I5)) break;
        int r = (int)base + F.wave; if (r >= I0 + I1 + I2 + I3 + I4 + I5) continue;
        if (r < I0) { transpose_item(F.in[I_ABWIN], 1024, ABIN, (bf16_t*)(F.ws + WS_WIN0), 64 * (r / 56), 64 * (r % 56), DMapId{}, scr, F.lane); continue; } r -= I0;
        if (r < I1) { transpose_item(F.in[I_ABWOUT], 1024, 1024, (bf16_t*)(F.ws + WS_WOUT0), 64 * (r / 16), 64 * (r % 16), DMapId{}, scr, F.lane); continue; } r -= I1;
        if (r < I2) { transpose_item(F.in[I_SWAWIN], 1024, SWAIN, (bf16_t*)(F.ws + WS_WIN1), 64 * (r / 24), 64 * (r % 24), DMapId{}, scr, F.lane); continue; } r -= I2;
        if (r < I3) { transpose_item(F.in[I_SWAWOUT], 1024, 1024, (bf16_t*)(F.ws + WS_WOUT1), 64 * (r / 16), 64 * (r % 16), DMapId{}, scr, F.lane); continue; } r -= I3;
        if (r < I4) { const int e = r / 256, q2 = r % 256;
            transpose_item8(F.in[I_WGU] + (size_t)e * 1024 * 1024, 1024, 1024, F.ws + WS_WGU + (size_t)e * 1024 * 1024, 64 * (q2 / 16), 64 * (q2 % 16), DMapGU{}, scr, F.lane); continue; } r -= I4;
        { const int e = r / 128, q2 = r % 128;
            transpose_item8(F.in[I_WDN] + (size_t)e * 512 * 1024, 512, 1024, F.ws + WS_WDN + (size_t)e * 1024 * 512, 64 * (q2 / 16), 64 * (q2 % 16), DMapGU{}, scr, F.lane); }
    }
}
__device__ __forceinline__ void conv_tail(Ctx& F, int first, int item0) {
    __syncthreads();
    if (F.blk < first) return;
    LAS float* scr = (LAS float*)(F.lds + F.wave * 17408);
    const int wi = (F.blk - first) * NWAVES + F.wave;
    for (int j = 0; j < 4; ++j) { const int it = item0 + wi * 4 + j; if (it >= 12288) break;
        if (it < 8192) { const int e = 32 + it / 256, q = it % 256;
            transpose_item8(F.in[I_WGU] + (size_t)e * 1024 * 1024, 1024, 1024, F.ws + WS_WGU + (size_t)e * 1024 * 1024, 64 * (q / 16), 64 * (q % 16), DMapGU{}, scr, F.lane); }
        else { const int r = it - 8192, e = 32 + r / 128, q = r % 128;
            transpose_item8(F.in[I_WDN] + (size_t)e * 512 * 1024, 512, 1024, F.ws + WS_WDN + (size_t)e * 1024 * 512, 64 * (q / 16), 64 * (q % 16), DMapGU{}, scr, F.lane); } }
}

struct RowMod { float a[16], s[16]; };
__device__ __forceinline__ void load_rowmod(const Ctx& F, int l, int which, int b, RowMod& M) {
    const float* mod = (const float*)(F.ws + WS_MOD) + (size_t)(l * 17 + b) * 6144;
    const float* g = F.in[I_NORMG] + (size_t)(l * 2 + which) * 1024;
#pragma unroll
    for (int j = 0; j < 4; ++j) { const int c = 4 * F.lane + 256 * j;
        const f32x4 gv = *(const f32x4*)(g + c), sh = *(const f32x4*)(mod + which * 3072 + c), sc = *(const f32x4*)(mod + which * 3072 + 1024 + c);
#pragma unroll
        for (int i = 0; i < 4; ++i) { M.a[4 * j + i] = gv[i] * (1.f + sc[i]); M.s[4 * j + i] = sh[i]; } }
}
__device__ __forceinline__ void load_row16(const float* p, int lane, float* v) {
#pragma unroll
    for (int j = 0; j < 4; ++j) { const f32x4 t = __builtin_nontemporal_load((const f32x4*)(p + 4 * lane + 256 * j)); v[4 * j] = t[0]; v[4 * j + 1] = t[1]; v[4 * j + 2] = t[2]; v[4 * j + 3] = t[3]; }
}
__device__ __forceinline__ void load_row16_bf16(const bf16_t* p, int lane, float* v) {
#pragma unroll
    for (int j = 0; j < 4; ++j) { const u32x2 w = *(const u32x2*)(p + 4 * lane + 256 * j); v[4 * j] = bf2f(w.x & 0xffffu); v[4 * j + 1] = bf2f(w.x >> 16); v[4 * j + 2] = bf2f(w.y & 0xffffu); v[4 * j + 3] = bf2f(w.y >> 16); }
}
__device__ __forceinline__ void load_row16_bf16_nt(const bf16_t* p, int lane, float* v) {
#pragma unroll
    for (int j = 0; j < 4; ++j) { const u32x2 w = __builtin_nontemporal_load((const u32x2*)(p + 4 * lane + 256 * j)); v[4 * j] = bf2f(w.x & 0xffffu); v[4 * j + 1] = bf2f(w.x >> 16); v[4 * j + 2] = bf2f(w.y & 0xffffu); v[4 * j + 3] = bf2f(w.y >> 16); }
}
__device__ __forceinline__ void store_row16_bf16(bf16_t* p, int lane, const float* v) {
#pragma unroll
    for (int j = 0; j < 4; ++j) { u32x2 w; w.x = pk2(v[4 * j], v[4 * j + 1]); w.y = pk2(v[4 * j + 2], v[4 * j + 3]); *(u32x2*)(p + 4 * lane + 256 * j) = w; }
}
__device__ __forceinline__ void store_row16_f32(float* p, int lane, const float* v) {
#pragma unroll
    for (int j = 0; j < 4; ++j) { f32x4 t = {v[4 * j], v[4 * j + 1], v[4 * j + 2], v[4 * j + 3]}; *(f32x4*)(p + 4 * lane + 256 * j) = t; }
}
__device__ __forceinline__ void store_row16_f32_nt(float* p, int lane, const float* v) {
#pragma unroll
    for (int j = 0; j < 4; ++j) { f32x4 t = {v[4 * j], v[4 * j + 1], v[4 * j + 2], v[4 * j + 3]}; __builtin_nontemporal_store(t, (f32x4*)(p + 4 * lane + 256 * j)); }
}
__device__ __forceinline__ float row_rstd(const float* v) {
    float ss = 0.f;
#pragma unroll
    for (int i = 0; i < 16; ++i) ss += v[i] * v[i];
    return rsqrtf(wave_sum(ss) * (1.f / 1024.f) + 1e-6f);
}

__device__ __forceinline__ const float* xrow_in(const Ctx& F, int row) { return row < NL ? F.in[I_X] + (size_t)row * D : F.in[I_CTX] + (size_t)(row - NL) * D; }
__device__ __forceinline__ bf16_t* xrow_cur(const Ctx& F, int row) { return (bf16_t*)(F.ws + WS_XB) + (size_t)row * D; }
__device__ __forceinline__ void wait_mod(Ctx& F) {
    if (F.tid == 0) { unsigned* flag = (unsigned*)(F.ws + WS_CTL) + 400; unsigned spins = 0;
        while (__hip_atomic_load(flag, __ATOMIC_RELAXED, __HIP_MEMORY_SCOPE_AGENT) < 192u) { __builtin_amdgcn_s_sleep(4); if (++spins > (1u << 22)) break; }
        __builtin_amdgcn_fence(__ATOMIC_ACQUIRE, "agent"); asm volatile("s_waitcnt vmcnt(0)" ::: "memory"); }
    __syncthreads();
}
__device__ __forceinline__ void phase_norm0(Ctx& F) {
    bf16_t* H = (bf16_t*)(F.ws + WS_H);
    const int r0 = (F.blk * NWAVES + F.wave) * 18, r1 = r0 + 18 < NTOK ? r0 + 18 : NTOK; int curb = -1; RowMod M;
    float nx[16]; if (r0 < r1) load_row16(xrow_in(F, r0), F.lane, nx);
    for (int row = r0; row < r1; ++row) {
        float v[16];
#pragma unroll
        for (int i = 0; i < 16; ++i) v[i] = nx[i];
        load_row16(xrow_in(F, row + 1 < r1 ? row + 1 : row), F.lane, nx);
        const int b = row < NL ? row >> 11 : 16;
        if (b != curb) { load_rowmod(F, 0, 0, b, M); curb = b; }
        const float rstd = row_rstd(v);
#pragma unroll
        for (int i = 0; i < 16; ++i) v[i] = v[i] * rstd * M.a[i] + M.s[i];
        store_row16_bf16(H + (size_t)row * D, F.lane, v);
    }
}

__device__ __forceinline__ void phase_cvec(Ctx& F) {
    if (F.blk >= 34) return;
    const int l = F.blk / 17, b = F.blk % 17;
    const float* sh = (const float*)(F.ws + WS_MOD) + (size_t)(l * 17 + b) * 6144 + 3072;
    LAS float* red = (LAS float*)F.lds;
    const int kg = F.tid >> 5, c = F.tid & 31;
    float acc = 0.f, accg = 0.f;
    for (int k = kg * 64; k < kg * 64 + 64; ++k) { const float sv = sh[k]; acc += sv * F.in[I_REW][(size_t)(l * 1024 + k) * 32 + c]; if (c < 4) accg += sv * F.in[I_RGW][(size_t)(l * 1024 + k) * 4 + c]; }
    red[kg * 36 + 4 + c] = acc; if (c < 4) red[kg * 36 + c] = accg;
    __syncthreads();
    if (F.tid < 36) { float v = F.tid < 4 ? F.in[I_RGB][l * 4 + F.tid] : F.in[I_REB][l * 32 + F.tid - 4];
#pragma unroll
        for (int g = 0; g < 16; ++g) v += red[g * 36 + F.tid];
        ((float*)(F.ws + WS_ROUTE + RT_CVEC))[(l * 17 + b) * 48 + F.tid] = v; }
    __syncthreads();
}
typedef float f32x4v __attribute__((ext_vector_type(4)));
__device__ __forceinline__ void phase_router(Ctx& F, int l, int nrows) {
    LAS float* av = (LAS float*)F.lds;
    LAS float* sv = av + 2048;
    LAS float* cv = sv + 2048;
    LAS int* cnt = (LAS int*)(cv + 96);
    LAS float* part = (LAS float*)(cnt + 32);
    LAS float* lgb = part + 2 * 8 * 16 * 52;
    const int row_lo = F.blk * 144; const int row_hi = row_lo + 144 < nrows ? row_lo + 144 : nrows;
    if (F.tid < 32) cnt[F.tid] = 0;
    if (row_lo < nrows) {
        const int b0 = row_lo < NL ? row_lo >> 11 : 16, b1 = (row_hi - 1) < NL ? (row_hi - 1) >> 11 : 16;
        const float* g = F.in[I_NORMG] + (size_t)(l * 2 + 1) * 1024;
        for (int idx = F.tid; idx < 2048; idx += NTHREADS) { const int w = idx >> 10, k = idx & 1023; const float* mod = (const float*)(F.ws + WS_MOD) + (size_t)(l * 17 + (w ? b1 : b0)) * 6144;
            av[idx] = g[k] * (1.f + mod[4096 + k]); sv[idx] = mod[3072 + k]; }
        if (F.tid < 96) { const int w = F.tid / 48, c = F.tid % 48; cv[F.tid] = c < 36 ? ((const float*)(F.ws + WS_ROUTE + RT_CVEC))[(l * 17 + (w ? b1 : b0)) * 48 + c] : 0.f; }
        int* tok_e = (int*)(F.ws + WS_ROUTE + RT_TOKE); float* tok_w = (float*)(F.ws + WS_ROUTE + RT_TOKW); int* tok_r = (int*)(F.ws + WS_ROUTE + RT_TOKR); float* rstd_o = (float*)(F.ws + WS_ROUTE + RT_RSTD);
        const bf16_t* whi = (const bf16_t*)(F.ws + WS_RW) + (size_t)(l * 2) * 49152; const bf16_t* wlo = whi + 49152;
        const int n = F.lane & 15, kq = F.lane >> 4, kw = 128 * F.wave + 8 * kq;
        bf16x8 Wh[4][3], Wl[4][3];
#pragma unroll
        for (int i = 0; i < 4; ++i)
#pragma unroll
            for (int cb = 0; cb < 3; ++cb) { Wh[i][cb] = *(const bf16x8*)(whi + (size_t)(cb * 16 + n) * 1024 + kw + 32 * i); Wl[i][cb] = *(const bf16x8*)(wlo + (size_t)(cb * 16 + n) * 1024 + kw + 32 * i); }
        const int ntask = (row_hi - row_lo) >> 4;
        u32x4 xq[4], xn[4];
#pragma unroll
        for (int i = 0; i < 4; ++i) xq[i] = *(const u32x4*)(xrow_cur(F, row_lo + n) + kw + 32 * i);
        __syncthreads();
        for (int task = 0; task < ntask; ++task) {
            const int r0 = row_lo + 16 * task; const int b = r0 < NL ? r0 >> 11 : 16; const int w = (b == b0) ? 0 : 1;
            { const int rn = task + 1 < ntask ? r0 + 16 : r0;
#pragma unroll
              for (int i = 0; i < 4; ++i) xn[i] = *(const u32x4*)(xrow_cur(F, rn + n) + kw + 32 * i); }
            f32x4v acc[3]; acc[0] = f32x4v{0.f, 0.f, 0.f, 0.f}; acc[1] = acc[0]; acc[2] = acc[0]; float ss = 0.f;
#pragma unroll
            for (int i = 0; i < 4; ++i) { const int k0 = kw + 32 * i;
                float xx[8]; unpack8(xq[i], xx);
                const f32x4 a0 = *(const LAS f32x4*)(av + w * 1024 + k0), a1 = *(const LAS f32x4*)(av + w * 1024 + k0 + 4);
                float xa[8]; unsigned hb[8]; float lo[8];
#pragma unroll
                for (int j = 0; j < 4; ++j) { xa[j] = xx[j] * a0[j]; xa[4 + j] = xx[4 + j] * a1[j]; ss += xx[j] * xx[j] + xx[4 + j] * xx[4 + j]; }
#pragma unroll
                for (int j = 0; j < 8; ++j) { hb[j] = f2bf(xa[j]); lo[j] = xa[j] - bf2f(hb[j]); }
                u32x4 bh, bl; bh.x = hb[0] | (hb[1] << 16); bh.y = hb[2] | (hb[3] << 16); bh.z = hb[4] | (hb[5] << 16); bh.w = hb[6] | (hb[7] << 16);
                bl.x = pk2(lo[0], lo[1]); bl.y = pk2(lo[2], lo[3]); bl.z = pk2(lo[4], lo[5]); bl.w = pk2(lo[6], lo[7]);
                const bf16x8 Bh = __builtin_bit_cast(bf16x8, bh), Bl = __builtin_bit_cast(bf16x8, bl);
#pragma unroll
                for (int cb = 0; cb < 3; ++cb) {
                    acc[cb] = __builtin_amdgcn_mfma_f32_16x16x32_bf16(Wh[i][cb], Bh, acc[cb], 0, 0, 0);
                    acc[cb] = __builtin_amdgcn_mfma_f32_16x16x32_bf16(Wh[i][cb], Bl, acc[cb], 0, 0, 0);
                    acc[cb] = __builtin_amdgcn_mfma_f32_16x16x32_bf16(Wl[i][cb], Bh, acc[cb], 0, 0, 0); }
                __builtin_amdgcn_sched_barrier(0); }
            ss += __shfl_xor(ss, 16); ss += __shfl_xor(ss, 32);
            LAS float* pb = part + ((task & 1) * 8 + F.wave) * 16 * 52 + n * 52;
#pragma unroll
            for (int cb = 0; cb < 3; ++cb) *(LAS f32x4v*)(pb + cb * 16 + 4 * kq) = acc[cb];
            if (kq == 0) pb[48] = ss;
            __syncthreads();
            { const LAS float* pq = part + (task & 1) * 8 * 16 * 52 + n * 52 + 48; float sq = 0.f;
#pragma unroll
              for (int ww = 0; ww < 8; ++ww) sq += pq[ww * 16 * 52];
              const float rstd = rsqrtf(sq * (1.f / 1024.f) + 1e-6f); unsigned char* hp = F.ws + WS_H + (size_t)(r0 + n) * D;
#pragma unroll
              for (int i = 0; i < 4; ++i) { const int k0 = kw + 32 * i; float xx[8], hh[8]; unpack8(xq[i], xx);
                  const f32x4 a0 = *(const LAS f32x4*)(av + w * 1024 + k0), a1 = *(const LAS f32x4*)(av + w * 1024 + k0 + 4), s0 = *(const LAS f32x4*)(sv + w * 1024 + k0), s1 = *(const LAS f32x4*)(sv + w * 1024 + k0 + 4);
#pragma unroll
                  for (int j = 0; j < 4; ++j) { hh[j] = xx[j] * rstd * a0[j] + s0[j]; hh[4 + j] = xx[4 + j] * rstd * a1[j] + s1[j]; }
                  u32x2 o; o.x = pk4_fp8(H8_SCALE * hh[0], H8_SCALE * hh[1], H8_SCALE * hh[2], H8_SCALE * hh[3]); o.y = pk4_fp8(H8_SCALE * hh[4], H8_SCALE * hh[5], H8_SCALE * hh[6], H8_SCALE * hh[7]);
                  *(u32x2*)(hp + k0) = o; } }
            { const LAS float* pr = part + (task & 1) * 8 * 16 * 52;
              for (int idx = F.tid; idx < 16 * 52; idx += NTHREADS) { const int rr = idx / 52, c = idx % 52;
                  if (c < 49) { float s = 0.f;
#pragma unroll
                      for (int ww = 0; ww < 8; ++ww) s += pr[(ww * 16 + rr) * 52 + c];
                      lgb[(task * 16 + rr) * 52 + c] = s; } } }
#pragma unroll
            for (int i = 0; i < 4; ++i) xq[i] = xn[i];
        }
        __syncthreads();
        const int nloc = ntask * 16; int e0 = 0, e1 = 0;
        if (F.tid < nloc) {
            const int row = row_lo + F.tid; const int b = row < NL ? row >> 11 : 16; const int w = (b == b0) ? 0 : 1; const LAS float* p0 = lgb + F.tid * 52;
            float lg[36];
#pragma unroll
            for (int c4 = 0; c4 < 9; ++c4) { const f32x4v t = *(const LAS f32x4v*)(p0 + 4 * c4); lg[4 * c4] = t[0]; lg[4 * c4 + 1] = t[1]; lg[4 * c4 + 2] = t[2]; lg[4 * c4 + 3] = t[3]; }
            const float rstd = rsqrtf(p0[48] * (1.f / 1024.f) + 1e-6f);
#pragma unroll
            for (int c = 0; c < 36; ++c) lg[c] = rstd * lg[c] + cv[w * 48 + c];
            int gi = 0; float gm = lg[0]; if (lg[1] > gm) { gm = lg[1]; gi = 1; } if (lg[2] > gm) { gm = lg[2]; gi = 2; } if (lg[3] > gm) { gm = lg[3]; gi = 3; }
            const float gwt = 1.f / (__expf(lg[0] - gm) + __expf(lg[1] - gm) + __expf(lg[2] - gm) + __expf(lg[3] - gm));
            float le[8];
#pragma unroll
            for (int i = 0; i < 8; ++i) { le[i] = lg[4 + i]; if (gi == 1) le[i] = lg[12 + i]; if (gi == 2) le[i] = lg[20 + i]; if (gi == 3) le[i] = lg[28 + i]; }
            int i0 = 0; float v0 = le[0];
#pragma unroll
            for (int i = 1; i < 8; ++i) if (le[i] > v0) { v0 = le[i]; i0 = i; }
            int i1 = -1; float v1 = -3.0e38f;
#pragma unroll
            for (int i = 0; i < 8; ++i) if (i != i0 && le[i] > v1) { v1 = le[i]; i1 = i; }
            const float ex = __expf(v1 - v0), t0 = 1.f / (1.f + ex), t1 = ex * t0;
            e0 = gi * 8 + i0; e1 = gi * 8 + i1;
            tok_e[row * 2] = e0; tok_e[row * 2 + 1] = e1; tok_w[row * 2] = gwt * t0; tok_w[row * 2 + 1] = gwt * t1;
            rstd_o[row] = rstd;
        }
        for (int wv = 0; wv < 3; ++wv) {
            if (F.wave == wv && F.tid < nloc) { const int row = row_lo + F.tid; tok_r[row * 2] = atomicAdd((int*)&cnt[e0], 1); tok_r[row * 2 + 1] = atomicAdd((int*)&cnt[e1], 1); }
            __syncthreads(); }
    }
    __syncthreads();
    if (F.tid < 32) ((int*)(F.ws + WS_ROUTE + RT_BCNT))[F.blk * 32 + F.tid] = cnt[F.tid];
}

__device__ __forceinline__ void phase_slots(Ctx& F, int l, int nrows) {
    LAS int* base = (LAS int*)F.lds;
    const int* bc = (const int*)(F.ws + WS_ROUTE + RT_BCNT);
    { const int g = F.tid >> 5, e = F.tid & 31; int tot = 0, below = 0;
      for (int b = g; b < F.nblk; b += 16) { const int c = bc[b * 32 + e]; tot += c; if (b < F.blk) below += c; }
      base[128 + g * 32 + e] = tot; base[640 + g * 32 + e] = below; }
    __syncthreads();
    if (F.tid < 32) { int tot = 0, below = 0;
#pragma unroll
        for (int g = 0; g < 16; ++g) { tot += base[128 + g * 32 + F.tid]; below += base[640 + g * 32 + F.tid]; }
        base[64 + F.tid] = (tot + 255) & ~255; base[F.tid] = below; }
    __syncthreads();
    if (F.tid == 0) { int off = 0; for (int e = 0; e < 32; ++e) { const int p = base[64 + e]; base[32 + e] = off; base[e] += off; off += p; }
        base[96] = off; }
    __syncthreads();
    if (F.blk == 0) { int* te = (int*)(F.ws + WS_ROUTE + RT_TILEE); const int nt = base[96] >> 8;
        for (int t = F.tid; t < nt; t += NTHREADS) { int e = 0; for (int q = 1; q < 32; ++q) if (base[32 + q] <= t * 256) e = q; te[t] = e; }
        if (F.tid == 0) te[320] = nt; }
    const int* tok_e = (const int*)(F.ws + WS_ROUTE + RT_TOKE); const int* tok_r = (const int*)(F.ws + WS_ROUTE + RT_TOKR); int* tok_s = (int*)(F.ws + WS_ROUTE + RT_TOKS);
    int* stok = (int*)(F.ws + WS_STOK);
    for (int i = F.tid; i < 288; i += NTHREADS) { const int row = F.blk * 144 + (i >> 1); if (row < nrows) { const int sl = base[tok_e[row * 2 + (i & 1)]] + tok_r[row * 2 + (i & 1)]; tok_s[row * 2 + (i & 1)] = sl; stok[sl] = row; } }
}

__device__ __forceinline__ void load_vec16w(const float* p, int lane, float* v) {
#pragma unroll
    for (int j = 0; j < 2; ++j) { const f32x4 a = *(const f32x4*)(p + 512 * j + 8 * lane), b = *(const f32x4*)(p + 512 * j + 8 * lane + 4);
        v[8 * j] = a[0]; v[8 * j + 1] = a[1]; v[8 * j + 2] = a[2]; v[8 * j + 3] = a[3]; v[8 * j + 4] = b[0]; v[8 * j + 5] = b[1]; v[8 * j + 6] = b[2]; v[8 * j + 7] = b[3]; }
}
__device__ __forceinline__ void load_row16w_nt(const bf16_t* p, int lane, u32x4* w) {
#pragma unroll
    for (int j = 0; j < 2; ++j) w[j] = __builtin_nontemporal_load((const u32x4*)(p + 512 * j + 8 * lane));
}
__device__ __forceinline__ void unpack16_fp8(const u32x4 y, float* f) {
    typedef float f2_t __attribute__((ext_vector_type(2)));
    const unsigned d[4] = {y.x, y.y, y.z, y.w};
#pragma unroll
    for (int k = 0; k < 4; ++k) { const f2_t a = __builtin_amdgcn_cvt_pk_f32_fp8((int)d[k], false), b = __builtin_amdgcn_cvt_pk_f32_fp8((int)d[k], true); f[4 * k] = a[0]; f[4 * k + 1] = a[1]; f[4 * k + 2] = b[0]; f[4 * k + 3] = b[1]; }
}
__device__ __forceinline__ void phase_combine_w(Ctx& F, int l) {
    const int nrows = l == 0 ? NTOK : NL;
    const int* tok_s = (const int*)(F.ws + WS_ROUTE + RT_TOKS); const float* tok_w = (const float*)(F.ws + WS_ROUTE + RT_TOKW);
    const unsigned char* Y = F.ws + WS_Y; bf16_t* H = (bf16_t*)(F.ws + WS_H);
    const float* mod = (const float*)(F.ws + WS_MOD);
    const int r0 = (F.blk * NWAVES + F.wave) * 18, r1 = r0 + 18 < nrows ? r0 + 18 : nrows; int curb = -1; float ma[16], ms[16], g2[16], fg[16];
    if (l == 1) load_vec16w(F.in[I_FINALG], F.lane, fg);
    if (r0 >= r1) return;
    u32x4 ax[2], ay0, ay1, bx[2], by0, by1; float aw0, aw1, bw0, bw1; int ps0, ps1; float pw0, pw1;
    auto clampr = [&](int r) { return r < r1 ? r : r1 - 1; };
    { const int sa = tok_s[r0 * 2], sb = tok_s[r0 * 2 + 1]; aw0 = tok_w[r0 * 2]; aw1 = tok_w[r0 * 2 + 1];
      load_row16w_nt(xrow_cur(F, r0), F.lane, ax); ay0 = __builtin_nontemporal_load((const u32x4*)(Y + (size_t)sa * 1024 + 16 * F.lane)); ay1 = __builtin_nontemporal_load((const u32x4*)(Y + (size_t)sb * 1024 + 16 * F.lane));
      const int rb = clampr(r0 + 1); const int sc = tok_s[rb * 2], sd = tok_s[rb * 2 + 1]; bw0 = tok_w[rb * 2]; bw1 = tok_w[rb * 2 + 1];
      load_row16w_nt(xrow_cur(F, rb), F.lane, bx); by0 = __builtin_nontemporal_load((const u32x4*)(Y + (size_t)sc * 1024 + 16 * F.lane)); by1 = __builtin_nontemporal_load((const u32x4*)(Y + (size_t)sd * 1024 + 16 * F.lane));
      const int rn = clampr(r0 + 2); ps0 = tok_s[rn * 2]; ps1 = tok_s[rn * 2 + 1]; pw0 = tok_w[rn * 2]; pw1 = tok_w[rn * 2 + 1]; }
    for (int row = r0; row < r1; ++row) {
        u32x4 x[2]; const u32x4 y0 = ay0, y1 = ay1; const float w0 = aw0 * 0.125f, w1 = aw1 * 0.125f;
        x[0] = ax[0]; x[1] = ax[1];
        ax[0] = bx[0]; ax[1] = bx[1]; ay0 = by0; ay1 = by1; aw0 = bw0; aw1 = bw1;
        { const int rn = clampr(row + 2), rn3 = clampr(row + 3);
          load_row16w_nt(xrow_cur(F, rn), F.lane, bx); by0 = __builtin_nontemporal_load((const u32x4*)(Y + (size_t)ps0 * 1024 + 16 * F.lane)); by1 = __builtin_nontemporal_load((const u32x4*)(Y + (size_t)ps1 * 1024 + 16 * F.lane)); bw0 = pw0; bw1 = pw1;
          ps0 = tok_s[rn3 * 2]; ps1 = tok_s[rn3 * 2 + 1]; pw0 = tok_w[rn3 * 2]; pw1 = tok_w[rn3 * 2 + 1]; }
        const int b = row < NL ? row >> 11 : 16;
        if (b != curb) {
            if (l == 0) { const float* m1 = mod + (size_t)(17 + b) * 6144; float gv[16], sc[16];
                load_vec16w(F.in[I_NORMG] + (size_t)2 * 1024, F.lane, gv); load_vec16w(m1, F.lane, ms); load_vec16w(m1 + 1024, F.lane, sc);
#pragma unroll
                for (int i = 0; i < 16; ++i) ma[i] = gv[i] * (1.f + sc[i]); }
            load_vec16w(mod + (size_t)(l * 17 + b) * 6144 + 5 * 1024, F.lane, g2); curb = b; }
        float v[16], ya[16], yb[16]; unpack16_fp8(y0, ya); unpack16_fp8(y1, yb);
#pragma unroll
        for (int j = 0; j < 2; ++j) { float xa[8]; unpack8(x[j], xa);
#pragma unroll
            for (int i = 0; i < 8; ++i) v[8 * j + i] = xa[i] + g2[8 * j + i] * (w0 * ya[8 * j + i] + w1 * yb[8 * j + i]); }
        const float rstd = row_rstd(v);
        if (l == 0) {
            bf16_t* xo = xrow_cur(F, row) + 8 * F.lane; bf16_t* ho = H + (size_t)row * D + 8 * F.lane;
            store8_bf16(xo, v); store8_bf16(xo + 512, v + 8);
#pragma unroll
            for (int i = 0; i < 16; ++i) v[i] = v[i] * rstd * ma[i] + ms[i];
            store8_bf16(ho, v); store8_bf16(ho + 512, v + 8);
        } else {
#pragma unroll
            for (int i = 0; i < 16; ++i) v[i] = v[i] * rstd * fg[i];
            float* op = F.out + (size_t)row * D + 8 * F.lane;
#pragma unroll
            for (int j = 0; j < 2; ++j) { const f32x4 t0 = {v[8 * j], v[8 * j + 1], v[8 * j + 2], v[8 * j + 3]}, t1 = {v[8 * j + 4], v[8 * j + 5], v[8 * j + 6], v[8 * j + 7]};
                __builtin_nontemporal_store(t0, (f32x4*)(op + 512 * j)); __builtin_nontemporal_store(t1, (f32x4*)(op + 512 * j + 4)); }
        }
    }
}

struct GemmDesc { const bf16_t* A; int lda; const bf16_t* Bt; int K; int nM, nN; const int* tile_e; size_t estride; const int* gather = nullptr; };

template <class Epi>
__device__ __forceinline__ void gemm_naive(Ctx& F, const GemmDesc g, const Epi& E) {
    const int wr = F.wave >> 2, wc = F.wave & 3, fr = F.lane & 15, fq = F.lane >> 4;
    const int nun = g.nM * g.nN;
    for (int u = F.blk; u < nun; u += F.nblk) {
        const int pm = u / g.nN, pn = u % g.nN;
        const bf16_t* Bt = g.Bt + (g.tile_e ? (size_t)g.tile_e[pm] * g.estride : 0);
        const bf16_t* bp = Bt + (size_t)(256 * pn + 32 * wc + 8 * fq) * g.K;
        for (int am = 0; am < 8; ++am) {
            const int ai = am >> 2, m = am & 3, row = 256 * pm + 128 * ai + 64 * wr + 16 * m + fr;
            const bf16_t* ap = g.A + (size_t)row * g.lda;
            float v0[8], v1[8];
#pragma unroll
            for (int i = 0; i < 8; ++i) { v0[i] = 0.f; v1[i] = 0.f; }
            for (int k0 = 0; k0 < g.K; k0 += 8) {
                float a[8]; unpack8(*(const u32x4*)(ap + k0), a);
#pragma unroll
                for (int i = 0; i < 8; ++i) { float b[8]; unpack8(*(const u32x4*)(bp + (size_t)i * g.K + k0), b);
#pragma unroll
                    for (int q = 0; q < 8; ++q) v0[i] += a[q] * b[q];
                    unpack8(*(const u32x4*)(bp + (size_t)(128 + i) * g.K + k0), b);
#pragma unroll
                    for (int q = 0; q < 8; ++q) v1[i] += a[q] * b[q]; }
            }
            E(row, pn, 32 * wc + 8 * fq, v0, v1);
        }
    }
}


#ifndef EPI_DIST
#define EPI_DIST 2
#endif
struct RopePre { f32x4 t[4]; };
__device__ __forceinline__ void rope_load(int row, int cl, const float* rt, RopePre& P) {
    const int fq = (cl >> 3) & 3, t = row & (SEQ - 1), axis = (cl >> 5) & 1, pos = axis ? (t & 63) : (t >> 6), f0 = 8 * (fq & 1);
    const f32x4* tp = (const f32x4*)(rt + (pos * 16 + f0) * 2);
    P.t[0] = tp[0]; P.t[1] = tp[1]; P.t[2] = tp[2]; P.t[3] = tp[3];
}
__device__ __forceinline__ void rope_apply(float* v, int cl, const RopePre& P) {
    const bool x2 = ((cl >> 3) & 3) >= 2;
    const float cs[16] = {P.t[0][0], P.t[0][1], P.t[0][2], P.t[0][3], P.t[1][0], P.t[1][1], P.t[1][2], P.t[1][3], P.t[2][0], P.t[2][1], P.t[2][2], P.t[2][3], P.t[3][0], P.t[3][1], P.t[3][2], P.t[3][3]};
#pragma unroll
    for (int i = 0; i < 8; ++i) { const unsigned u = __float_as_uint(v[i]); auto rr = __builtin_amdgcn_permlane32_swap(u, u, false, false);
        const float p = __uint_as_float(x2 ? rr[0] : rr[1]); const float c = cs[2 * i], sn = cs[2 * i + 1];
        v[i] = x2 ? v[i] * c + p * sn : v[i] * c - p * sn; }
}
struct RopeUnit { bool rope; float sc; };
struct EpiIn0 { static constexpr bool PREFETCH = true; static constexpr int NST = 16; static constexpr int NPRE = EPI_DIST; typedef RopePre Pre; typedef RopeUnit UPre; bf16_t* O; const float* rt;
    __device__ __forceinline__ void uload(int pm, int pn, int cl, UPre& G) const { G.rope = pn < 4 && pm * 256 < NL; G.sc = (pn == 2 || pn == 3) ? 0.125f : ((pn == 8 || pn == 9) ? 0.125f * LOG2E : 1.f); }
    __device__ __forceinline__ bool variant(const UPre& G) const { return G.rope; }
    template <bool R> __device__ __forceinline__ void load(int row, int pn, int cl, Pre& P, const UPre& G) const { if constexpr (R) rope_load(row, cl, rt, P); }
    template <bool R> __device__ __forceinline__ void apply(int row, int pn, int cl, float* v0, float* v1, const Pre& P, const UPre& G) const {
        if constexpr (R) { rope_apply(v0, cl, P); rope_apply(v1, cl, P); }
#pragma unroll
        for (int i = 0; i < 8; ++i) { v0[i] *= G.sc; v1[i] *= G.sc; }
        bf16_t* p = O + (size_t)row * ABIN + 256 * pn + cl; store8_bf16(p, v0); store8_bf16(p + 128, v1);
    } };
struct EpiIn1 { static constexpr bool PREFETCH = true; static constexpr int NST = 16; static constexpr int NPRE = EPI_DIST; typedef RopePre Pre; typedef RopeUnit UPre; bf16_t* O; const float* rt; int col0; int rowoff;
    __device__ __forceinline__ void uload(int pm, int pn, int cl, UPre& G) const { G.rope = rowoff + pm * 256 < NL && col0 + 256 * pn < 1280; G.sc = col0 + 256 * pn < 1024 ? 0.125f * LOG2E : 1.f; }
    __device__ __forceinline__ bool variant(const UPre& G) const { return G.rope; }
    template <bool R> __device__ __forceinline__ void load(int row, int pn, int cl, Pre& P, const UPre& G) const { if constexpr (R) rope_load(row + rowoff, cl, rt, P); }
    template <bool R> __device__ __forceinline__ void apply(int row, int pn, int cl, float* v0, float* v1, const Pre& P, const UPre& G) const {
        const int c = col0 + 256 * pn; row += rowoff;
        if constexpr (R) { rope_apply(v0, cl, P); rope_apply(v1, cl, P); }
#pragma unroll
        for (int i = 0; i < 8; ++i) { v0[i] *= G.sc; v1[i] *= G.sc; }
        bf16_t* p = O + (size_t)row * SWAIN + c + cl; store8_bf16(p, v0); store8_bf16(p + 128, v1);
    } };
struct EpiResPre { float xo[16]; };
struct EpiResUnit { f32x4 g[4]; const float* xsrc; };
template <bool L0>
struct EpiResT { static constexpr bool PREFETCH = true; static constexpr int NST = 16; static constexpr int NPRE = L0 ? EPI_DIST : 7; typedef EpiResPre Pre; typedef EpiResUnit UPre; const float* xl; const float* xc; bf16_t* xb; const float* mod;
    __device__ __forceinline__ void uload(int pm, int pn, int cl, UPre& G) const { const int b = pm * 256 < NL ? pm >> 3 : 16; const float* g = mod + (size_t)b * 6144 + 2048 + 256 * pn + cl;
        G.g[0] = *(const f32x4*)g; G.g[1] = *(const f32x4*)(g + 4); G.g[2] = *(const f32x4*)(g + 128); G.g[3] = *(const f32x4*)(g + 132);
        G.xsrc = nullptr; if constexpr (L0) G.xsrc = pm * 256 < NL ? xl + (size_t)pm * 256 * D : xc + ((size_t)pm * 256 - NL) * D; }
    __device__ __forceinline__ bool variant(const UPre&) const { return false; }
    template <bool R> __device__ __forceinline__ void load(int row, int pn, int cl, Pre& P, const UPre& G) const {
#pragma unroll
        for (int h = 0; h < 2; ++h) { const int c = 256 * pn + cl + 128 * h;
            if constexpr (L0) { const float* src = G.xsrc + (size_t)(row & 255) * D + c;
                const f32x4 x0 = __builtin_nontemporal_load((const f32x4*)src), x1 = __builtin_nontemporal_load((const f32x4*)(src + 4)); P.xo[8 * h] = x0[0]; P.xo[8 * h + 1] = x0[1]; P.xo[8 * h + 2] = x0[2]; P.xo[8 * h + 3] = x0[3]; P.xo[8 * h + 4] = x1[0]; P.xo[8 * h + 5] = x1[1]; P.xo[8 * h + 6] = x1[2]; P.xo[8 * h + 7] = x1[3]; }
            else unpack8(*(const u32x4*)(xb + (size_t)row * D + c), P.xo + 8 * h); } }
    template <bool R> __device__ __forceinline__ void apply(int row, int pn, int cl, float* v0, float* v1, const Pre& P, const UPre& G) const {
        bf16_t* dst = xb + (size_t)row * D;
#pragma unroll
        for (int h = 0; h < 2; ++h) { float* v = h ? v1 : v0; const int c = 256 * pn + cl + 128 * h;
            const f32x4 g0 = G.g[2 * h], g1 = G.g[2 * h + 1]; float o[8];
#pragma unroll
            for (int i = 0; i < 4; ++i) { o[i] = P.xo[8 * h + i] + g0[i] * v[i]; o[4 + i] = P.xo[8 * h + 4 + i] + g1[i] * v[4 + i]; }
            store8_bf16(dst + c, o); } }
};
struct EpiGU { static constexpr int NST = 8; static constexpr bool F8 = true; static constexpr bool F8W = true; unsigned char* O;
    __device__ __forceinline__ void operator()(int row, int pn, int cl, float* v0, float* v1) const {
        float a[8]; constexpr float inv = 1.f / (H8_SCALE * W8_SCALE);
#pragma unroll
        for (int i = 0; i < 8; ++i) { const float g = v0[i] * inv, u = v1[i] * inv; a[i] = A8_SCALE * g * __builtin_amdgcn_rcpf(1.f + __builtin_amdgcn_exp2f(-LOG2E * g)) * u; }
        u32x2 o; o.x = pk4_fp8(a[0], a[1], a[2], a[3]); o.y = pk4_fp8(a[4], a[5], a[6], a[7]);
        *(u32x2*)(O + (size_t)row * FF + 128 * pn + cl) = o;
    } };
struct EpiY { static constexpr int NST = 8; static constexpr bool F8 = true; static constexpr bool F8W = true; unsigned char* O;
    __device__ __forceinline__ void operator()(int row, int pn, int cl, float* v0, float* v1) const {
        constexpr float inv = 1.f / (A8_SCALE * W8_SCALE);
#pragma unroll
        for (int i = 0; i < 8; ++i) { v0[i] *= inv; v1[i] *= inv; }
        u32x4 w; w.x = pk4_fp8(8.f * v0[0], 8.f * v0[1], 8.f * v0[2], 8.f * v0[3]); w.y = pk4_fp8(8.f * v0[4], 8.f * v0[5], 8.f * v0[6], 8.f * v0[7]);
        w.z = pk4_fp8(8.f * v1[0], 8.f * v1[1], 8.f * v1[2], 8.f * v1[3]); w.w = pk4_fp8(8.f * v1[4], 8.f * v1[5], 8.f * v1[6], 8.f * v1[7]);
        *(u32x4*)(O + (size_t)row * 1024 + 16 * (16 * pn + (cl >> 3))) = w;
    } };


struct EpiResPre;
namespace pg8 {
#define PG8_LAS __attribute__((address_space(3)))
typedef short bf16x8 __attribute__((ext_vector_type(8)));
constexpr int BM = 256, BK = 64, HALF = 128, HTB = HALF * BK * 2, STAGE_BYTES = 8 * HTB, NXCD = 8, WGM = 8;
__host__ __device__ __forceinline__ int lds_byte(int r, int c) { const int st = (r >> 4) * 2 + (c >> 5), rr = r & 15, cc = c & 31, ob = rr * 64 + cc * 2; return st * 1024 + (ob ^ (((ob >> 9) & 1) << 5)); }
__host__ __device__ __forceinline__ void stage_rc(int b, int& R, int& C) { const int st = b / 1024, sb = b % 1024, swz = sb ^ (((sb >> 9) & 1) << 5); R = (st >> 1) * 16 + swz / 64; C = (st & 1) * 32 + (swz % 64) / 2; }
__host__ __device__ __forceinline__ int perm32(int rho) { const int n = rho >> 4, i = rho & 15; return 8 * (i >> 2) + 4 * n + (i & 3); }
struct Unit { int pm, pn; };
struct Gemm { const bf16_t* A; const bf16_t* Bt; int K; const int* tile_e; size_t estride; const int* gather; };
__device__ __forceinline__ const char* unit_b(const Gemm& g, const Unit& u, size_t tstep, const PG8_LAS int* te, int i) {
    const bf16_t* b = g.Bt; if (g.tile_e) b += (size_t)__builtin_amdgcn_readfirstlane(te[i & 7]) * g.estride; return (const char*)b + (size_t)u.pn * tstep; }
struct StaticOrder {
    int nM, nN, nwg, G, c;
    __device__ void init(int nM_, int nN_, int G_, int c_) { nM = nM_; nN = nN_; nwg = nM * nN; G = G_; c = c_; }
    __device__ bool next(int i, Unit& u) const {
        const long L = (long)i * G + c; if (L >= nwg) return false;
        int wgid = (int)L; { const int q = nwg / NXCD, r = nwg % NXCD, xcd = wgid % NXCD, off = wgid / NXCD; wgid = (xcd < r ? xcd * (q + 1) : r * (q + 1) + (xcd - r) * q) + off; }
        const int nig = WGM * nN, gid = wgid / nig, fm = gid * WGM, gsz = (nM - fm) < WGM ? (nM - fm) : WGM;
        u.pm = fm + ((wgid % nig) % gsz); u.pn = (wgid % nig) / gsz; return true;
    }
    __device__ __forceinline__ void a_ready(const Unit&) const {}
    __device__ __forceinline__ void done(const Unit&) const {}
};
typedef int i32x4v __attribute__((ext_vector_type(4)));
typedef int i32x8v __attribute__((ext_vector_type(8)));
typedef long i64x2v __attribute__((ext_vector_type(2)));
template <class Epi> struct epi_is_f8 { template <class T> static constexpr bool test(decltype(T::F8)*) { return T::F8; } template <class T> static constexpr bool test(...) { return false; } static constexpr bool value = test<Epi>(nullptr); };
template <class Epi> struct epi_is_f8w { template <class T> static constexpr bool test(decltype(T::F8W)*) { return T::F8W; } template <class T> static constexpr bool test(...) { return false; } static constexpr bool value = test<Epi>(nullptr); };
template <class Epi> struct epi_has_prefetch { template <class T> static constexpr bool test(decltype(T::PREFETCH)*) { return T::PREFETCH; } template <class T> static constexpr bool test(...) { return false; } static constexpr bool value = test<Epi>(nullptr); };
template <class Epi, bool V>
__device__ __forceinline__ void run_epi_pre(const f32x4 (&acc)[2][2][4][2], const Unit& u, int wr, int wc, int fr, int fq, const Epi& E, const typename Epi::UPre& G) {
    constexpr int DIST = Epi::NPRE, NS = DIST + 1;
    typename Epi::Pre P[NS];
#pragma unroll
    for (int am = 0; am < DIST; ++am) E.template load<V>(u.pm * BM + (am >> 2) * HALF + wr * 64 + (am & 3) * 16 + fr, u.pn, wc * 32 + fq * 8, P[am % NS], G);
#pragma unroll
    for (int r = 0; r < 8; ++r) {
        if (r + DIST < 8) { const int am = r + DIST; E.template load<V>(u.pm * BM + (am >> 2) * HALF + wr * 64 + (am & 3) * 16 + fr, u.pn, wc * 32 + fq * 8, P[am % NS], G); }
        const int ai = r >> 2, m = r & 3; const int row = u.pm * BM + ai * HALF + wr * 64 + m * 16 + fr; float v0[8], v1[8];
#pragma unroll
        for (int i = 0; i < 4; ++i) { v0[i] = acc[ai][0][m][0][i]; v0[4 + i] = acc[ai][0][m][1][i]; v1[i] = acc[ai][1][m][0][i]; v1[4 + i] = acc[ai][1][m][1][i]; }
        E.template apply<V>(row, u.pn, wc * 32 + fq * 8, v0, v1, P[r % NS], G);
    }
}
template <class Epi>
__device__ __forceinline__ void run_epi(const f32x4 (&acc)[2][2][4][2], const Unit& u, int wr, int wc, int fr, int fq, const Epi& E) {
    if constexpr (epi_has_prefetch<Epi>::value) {
        typename Epi::UPre G; E.uload(u.pm, u.pn, wc * 32 + fq * 8, G);
        if (E.variant(G)) run_epi_pre<Epi, true>(acc, u, wr, wc, fr, fq, E, G); else run_epi_pre<Epi, false>(acc, u, wr, wc, fr, fq, E, G);
    } else {
#pragma unroll
        for (int ai = 0; ai < 2; ++ai) {
#pragma unroll
            for (int m = 0; m < 4; ++m) { const int row = u.pm * BM + ai * HALF + wr * 64 + m * 16 + fr; float v0[8], v1[8];
#pragma unroll
                for (int i = 0; i < 4; ++i) { v0[i] = acc[ai][0][m][0][i]; v0[4 + i] = acc[ai][0][m][1][i]; v1[i] = acc[ai][1][m][0][i]; v1[4 + i] = acc[ai][1][m][1][i]; }
                E(row, u.pn, wc * 32 + fq * 8, v0, v1); }
        }
    }
}
template <class Epi, class Sched, bool ALIGN_EPI = false, bool SP2 = false>
__device__ __forceinline__ void gemm_phase(PG8_LAS unsigned char* lds, const Gemm g, const Sched& S, const Epi& E, const int tid_in) {
    const int tid = tid_in, wid = __builtin_amdgcn_readfirstlane(tid >> 6), lane = tid & 63, wr = wid >> 2, wc = wid & 3, fr = lane & 15, fq = lane >> 4;
    const int K = g.K; int nt = K / BK; asm volatile("" : "+s"(nt));
    unsigned voffA[2], voffB[2];
#pragma unroll
    for (int i = 0; i < 2; ++i) { int R, C; stage_rc(tid * 16 + i * 8192, R, C); const int Rb = ((R & ~31) + perm32(R & 31));
        voffA[i] = (unsigned)(R * K + C) * 2u; voffB[i] = (unsigned)(Rb * K + C) * 2u; }
    unsigned voC[2][2], voN[2][2]; int gR[2], gC[2];
#pragma unroll
    for (int i = 0; i < 2; ++i) { int R, C; stage_rc(tid * 16 + i * 8192, R, C); gR[i] = R; gC[i] = C; voC[0][i] = voC[1][i] = voN[0][i] = voN[1][i] = voffA[i]; }
    const size_t kstep = (size_t)(BK * 2);
    const size_t hstep = (size_t)HALF * K * 2;
    const size_t tstep = 2 * hstep;
    const size_t ahs = g.gather ? 0 : hstep;
#define PG8_GATHER(vo, ui_) do { if (g.gather) { _Pragma("unroll") for (int h_ = 0; h_ < 2; ++h_) _Pragma("unroll") for (int i_ = 0; i_ < 2; ++i_) { \
        int l_; asm volatile("v_mbcnt_lo_u32_b32 %0, -1, 0\n\tv_mbcnt_hi_u32_b32 %0, -1, %0" : "=v"(l_)); int R_, C_; stage_rc((wid * 64 + l_) * 16 + i_ * 8192, R_, C_); \
        const int tk_ = gm[((ui_) & 7) * BM + h_ * HALF + R_]; (vo)[h_][i_] = (unsigned)(((unsigned)tk_ < (unsigned)NTOK ? tk_ : 0) * K + C_) * 2u; } } } while (0)
    const unsigned ldsw = (unsigned)wid * 1024u;
    const int aoff = lds_byte(wr * 64 + fr, fq * 8), boff = lds_byte(wc * 32 + fr, fq * 8);
#define PG8_SA(b, h) (((b) * 2 + (h)) * HTB)
#define PG8_SB(b, h) ((4 + (b) * 2 + (h)) * HTB)
#define PG8_STAGE(bufoff, gbase, voff) do { const char* gb_ = (const char*)(gbase); asm volatile("" : "+s"(gb_));     \
        _Pragma("unroll") for (int _i = 0; _i < 2; ++_i) \
        __builtin_amdgcn_global_load_lds((const unsigned*)(gb_ + (voff)[_i]), (PG8_LAS unsigned*)(lds + (bufoff) + ldsw + _i * 8192), 16, 0, 0); } while (0)
    constexpr bool F8W = epi_is_f8w<Epi>::value;
#define PG8_LDA(dst, b, h) do { _Pragma("unroll") for (int m = 0; m < 4; ++m) { if constexpr (F8W) { if (m < 2) { dst##8[m].lo = *(const PG8_LAS i32x4v*)(lds + PG8_SA(b, h) + aoff + m * 2048); dst##8[m].hi = *(const PG8_LAS i32x4v*)(lds + PG8_SA(b, h) + aoff + m * 2048 + 1024); } } \
        else { _Pragma("unroll") for (int k = 0; k < 2; ++k) dst[m][k] = *(const PG8_LAS bf16x8*)(lds + PG8_SA(b, h) + aoff + m * 2048 + k * 1024); } } } while (0)
#define PG8_LDB(dst, b, h) do { _Pragma("unroll") for (int n = 0; n < 2; ++n) { if constexpr (F8W) { dst##8[n].lo = *(const PG8_LAS i32x4v*)(lds + PG8_SB(b, h) + boff + n * 2048); dst##8[n].hi = *(const PG8_LAS i32x4v*)(lds + PG8_SB(b, h) + boff + n * 2048 + 1024); } \
        else { _Pragma("unroll") for (int k = 0; k < 2; ++k) dst[n][k] = *(const PG8_LAS bf16x8*)(lds + PG8_SB(b, h) + boff + n * 2048 + k * 1024); } } } while (0)
    constexpr bool F8 = epi_is_f8<Epi>::value;
#define PG8_MMA(ai, bj, At, Bt) do { __builtin_amdgcn_s_setprio(1); _Pragma("unroll") for (int m = 0; m < 4; ++m) _Pragma("unroll") for (int n = 0; n < 2; ++n) _Pragma("unroll") for (int k = 0; k < 2; ++k) { \
        if constexpr (F8) { const i64x2v b_ = __builtin_bit_cast(i64x2v, Bt[n][k]), a_ = __builtin_bit_cast(i64x2v, At[m][k]); \
            acc[ai][bj][m][n] = __builtin_amdgcn_mfma_f32_16x16x32_fp8_fp8(b_[0], a_[0], acc[ai][bj][m][n], 0, 0, 0); acc[ai][bj][m][n] = __builtin_amdgcn_mfma_f32_16x16x32_fp8_fp8(b_[1], a_[1], acc[ai][bj][m][n], 0, 0, 0); } \
        else acc[ai][bj][m][n] = __builtin_amdgcn_mfma_f32_16x16x32_bf16(Bt[n][k], At[m][k], acc[ai][bj][m][n], 0, 0, 0); } \
        __builtin_amdgcn_s_setprio(0); } while (0)
#define PG8_MMA_AB(ai, b_, h_) do { if constexpr (F8W) { \
        __builtin_amdgcn_s_setprio(1); _Pragma("unroll") for (int m = 0; m < 2; ++m) _Pragma("unroll") for (int n = 0; n < 2; ++n) { \
            acc[ai][0][m][n] = __builtin_amdgcn_mfma_scale_f32_16x16x128_f8f6f4(B08[n], At8[m], acc[ai][0][m][n], 0, 0, 0, 0, 0, 0); acc[ai][1][m][n] = __builtin_amdgcn_mfma_scale_f32_16x16x128_f8f6f4(B18[n], At8[m], acc[ai][1][m][n], 0, 0, 0, 0, 0, 0); } \
        __builtin_amdgcn_s_setprio(0); PG8_SCHED; \
        _Pragma("unroll") for (int m = 0; m < 2; ++m) { At8[m].lo = *(const PG8_LAS i32x4v*)(lds + PG8_SA(b_, h_) + aoff + (m + 2) * 2048); At8[m].hi = *(const PG8_LAS i32x4v*)(lds + PG8_SA(b_, h_) + aoff + (m + 2) * 2048 + 1024); } \
        PG8_WAIT_L(0); PG8_SCHED; \
        __builtin_amdgcn_s_setprio(1); _Pragma("unroll") for (int m = 0; m < 2; ++m) _Pragma("unroll") for (int n = 0; n < 2; ++n) { \
            acc[ai][0][m + 2][n] = __builtin_amdgcn_mfma_scale_f32_16x16x128_f8f6f4(B08[n], At8[m], acc[ai][0][m + 2][n], 0, 0, 0, 0, 0, 0); acc[ai][1][m + 2][n] = __builtin_amdgcn_mfma_scale_f32_16x16x128_f8f6f4(B18[n], At8[m], acc[ai][1][m + 2][n], 0, 0, 0, 0, 0, 0); } \
        __builtin_amdgcn_s_setprio(0); } \
    else { PG8_MMA(ai, 0, At, B0); PG8_MMA(ai, 1, At, B1); } } while (0)
#define PG8_WAIT_V(n) asm volatile("s_waitcnt vmcnt(" #n ")" ::: "memory")
#define PG8_WAIT_L(n) asm volatile("s_waitcnt lgkmcnt(" #n ")" ::: "memory")
    constexpr bool PRESTAGE = ALIGN_EPI && SP2 && (Epi::NST == 8 || Epi::NST == 16);
#define PG8_WAIT_VR(rel) do { if constexpr (!PRESTAGE) PG8_WAIT_V(8); \
        else if constexpr (Epi::NST == 16) asm volatile("s_waitcnt vmcnt(24)\n\ts_cmp_lg_u32 %0, 0\n\ts_cbranch_scc1 .Lpg8w%=\n\ts_waitcnt vmcnt(8)\n.Lpg8w%=:" :: "s"(rel) : "memory", "scc"); \
        else asm volatile("s_waitcnt vmcnt(16)\n\ts_cmp_lg_u32 %0, 0\n\ts_cbranch_scc1 .Lpg8w%=\n\ts_waitcnt vmcnt(8)\n.Lpg8w%=:" :: "s"(rel) : "memory", "scc"); } while (0)
#define PG8_BAR __builtin_amdgcn_s_barrier()
#define PG8_SCHED __builtin_amdgcn_sched_barrier(0)
    Unit cur, nxt; int ui = 0;
    PG8_LAS int* te = (PG8_LAS int*)(lds + STAGE_BYTES);
    PG8_LAS int* gm = te + 16;
    if (g.tile_e || g.gather) {
        if (g.tile_e) { if (tid < 8) { Unit u8; te[tid] = S.next(tid, u8) ? g.tile_e[u8.pm] : 0; } }
        if (g.gather) { for (int idx = tid; idx < 8 * BM; idx += 512) { Unit u8; gm[idx] = S.next(idx >> 8, u8) ? g.gather[u8.pm * BM + (idx & 255)] : 0; } }
        asm volatile("s_waitcnt vmcnt(0) lgkmcnt(0)" ::: "memory"); PG8_BAR; }
    if (!S.next(0, cur)) return;
    f32x4 acc[2][2][4][2];
#pragma unroll
    for (int a = 0; a < 2; ++a)
#pragma unroll
        for (int b = 0; b < 2; ++b)
#pragma unroll
            for (int m = 0; m < 4; ++m)
#pragma unroll
                for (int n = 0; n < 2; ++n) acc[a][b][m][n] = (f32x4){0.f, 0.f, 0.f, 0.f};
    bf16x8 At[4][2], B0[2][2], B1[2][2]; i32x8v At8[2], B08[2], B18[2];
    const char* cA = g.gather ? (const char*)g.A : (const char*)g.A + (size_t)cur.pm * tstep; const char* cB = unit_b(g, cur, tstep, te, 0);
    PG8_GATHER(voC, 0);
    S.a_ready(cur);
    if constexpr (SP2) {
        PG8_STAGE(PG8_SB(0, 0), cB, voffB); PG8_STAGE(PG8_SB(0, 1), cB + hstep, voffB); PG8_STAGE(PG8_SA(0, 0), cA, voC[0]); PG8_STAGE(PG8_SA(0, 1), cA + ahs, voC[1]);
        if (wr == 1) PG8_BAR;
        PG8_WAIT_V(2); PG8_BAR;
        PG8_STAGE(PG8_SB(1, 0), cB + kstep, voffB); PG8_STAGE(PG8_SA(1, 0), cA + kstep, voC[0]); PG8_STAGE(PG8_SB(1, 1), cB + hstep + kstep, voffB);
        PG8_WAIT_V(6); PG8_BAR;
    } else {
        PG8_STAGE(PG8_SB(0, 0), cB, voffB); PG8_STAGE(PG8_SA(0, 0), cA, voC[0]); PG8_STAGE(PG8_SB(0, 1), cB + hstep, voffB); PG8_STAGE(PG8_SA(0, 1), cA + ahs, voC[1]);
        if (wr == 1) PG8_BAR;
        PG8_WAIT_V(4); PG8_BAR;
        PG8_STAGE(PG8_SB(1, 0), cB + kstep, voffB); PG8_STAGE(PG8_SA(1, 0), cA + kstep, voC[0]); PG8_STAGE(PG8_SB(1, 1), cB + hstep + kstep, voffB);
        PG8_WAIT_V(6); PG8_BAR;
    }
    for (;;) {
        const bool has_next = S.next(ui + 1, nxt);
        const char* nA = (has_next && !g.gather) ? (const char*)g.A + (size_t)nxt.pm * tstep : cA; const char* nB = has_next ? unit_b(g, nxt, tstep, te, ui + 1) : cB;
#pragma unroll 1
        for (int t = 0; t < nt; t += 2) {
            const bool last = (t == nt - 2);
            const char* a1 = cA + (size_t)(t + 1) * kstep;
            const char* a2 = last ? nA : cA + (size_t)(t + 2) * kstep; const char* b2 = last ? nB : cB + (size_t)(t + 2) * kstep;
            const char* a3 = a2 + kstep; const char* b3 = b2 + kstep;
            unsigned v2[2][2];
#pragma unroll
            for (int h_ = 0; h_ < 2; ++h_)
#pragma unroll
                for (int i_ = 0; i_ < 2; ++i_) v2[h_][i_] = voC[h_][i_];
            if (g.gather) { unsigned vn_[2][2]; PG8_GATHER(vn_, ui + 1);
                _Pragma("unroll") for (int h_ = 0; h_ < 2; ++h_) _Pragma("unroll") for (int i_ = 0; i_ < 2; ++i_) v2[h_][i_] = last ? vn_[h_][i_] : voC[h_][i_]; }
            if (last && has_next) S.a_ready(nxt);
            if constexpr (SP2) {
            const int rel = __builtin_amdgcn_readfirstlane((PRESTAGE && t == 0 && ui > 0) ? 1 : 0);
            PG8_LDB(B0, 0, 0); PG8_LDB(B1, 0, 1); PG8_SCHED; PG8_LDA(At, 0, 0); PG8_STAGE(PG8_SA(1, 1), a1 + ahs, (g.gather ? voC[1] : voffA));
            PG8_WAIT_VR(rel); PG8_WAIT_L(0); PG8_BAR; PG8_MMA_AB(0, 0, 0); PG8_BAR; PG8_SCHED;
            PG8_LDA(At, 0, 1); PG8_STAGE(PG8_SB(0, 0), b2, voffB); PG8_STAGE(PG8_SB(0, 1), b2 + hstep, voffB); PG8_STAGE(PG8_SA(0, 0), a2, (g.gather ? v2[0] : voffA));
            PG8_WAIT_VR(rel); PG8_WAIT_L(0); PG8_BAR; PG8_MMA_AB(1, 0, 1); PG8_BAR; PG8_SCHED;
            PG8_LDB(B0, 1, 0); PG8_LDB(B1, 1, 1); PG8_SCHED; PG8_LDA(At, 1, 0); PG8_STAGE(PG8_SA(0, 1), a2 + ahs, (g.gather ? v2[1] : voffA));
            PG8_WAIT_VR(rel); PG8_WAIT_L(0); PG8_BAR; PG8_MMA_AB(0, 1, 0); PG8_BAR; PG8_SCHED;
            PG8_LDA(At, 1, 1); PG8_STAGE(PG8_SB(1, 0), b3, voffB); PG8_STAGE(PG8_SB(1, 1), b3 + hstep, voffB); PG8_STAGE(PG8_SA(1, 0), a3, (g.gather ? v2[0] : voffA));
            PG8_WAIT_V(8); PG8_WAIT_L(0); PG8_BAR; PG8_MMA_AB(1, 1, 1); PG8_BAR; PG8_SCHED;
            } else {
            PG8_LDB(B0, 0, 0); PG8_SCHED; PG8_LDA(At, 0, 0); PG8_STAGE(PG8_SA(1, 1), a1 + ahs, (g.gather ? voC[1] : voffA));
            PG8_WAIT_L(8); PG8_BAR; PG8_WAIT_L(0); PG8_MMA(0, 0, At, B0); PG8_BAR; PG8_SCHED;
            PG8_LDB(B1, 0, 1); PG8_STAGE(PG8_SB(0, 0), b2, voffB);
            PG8_BAR; PG8_WAIT_L(0); PG8_MMA(0, 1, At, B1); PG8_BAR;
            PG8_LDA(At, 0, 1); PG8_STAGE(PG8_SA(0, 0), a2, (g.gather ? v2[0] : voffA));
            PG8_BAR; PG8_WAIT_L(0); PG8_MMA(1, 0, At, B0); PG8_BAR; PG8_SCHED;
            PG8_STAGE(PG8_SB(0, 1), b2 + hstep, voffB);
            PG8_WAIT_V(6); PG8_BAR; PG8_MMA(1, 1, At, B1); PG8_BAR;
            PG8_LDB(B0, 1, 0); PG8_SCHED; PG8_LDA(At, 1, 0); PG8_STAGE(PG8_SA(0, 1), a2 + ahs, (g.gather ? v2[1] : voffA));
            PG8_WAIT_L(8); PG8_BAR; PG8_WAIT_L(0); PG8_MMA(0, 0, At, B0); PG8_BAR; PG8_SCHED;
            PG8_LDB(B1, 1, 1); PG8_STAGE(PG8_SB(1, 0), b3, voffB);
            PG8_BAR; PG8_WAIT_L(0); PG8_MMA(0, 1, At, B1); PG8_BAR;
            PG8_LDA(At, 1, 1); PG8_STAGE(PG8_SA(1, 0), a3, (g.gather ? v2[0] : voffA));
            PG8_BAR; PG8_WAIT_L(0); PG8_MMA(1, 0, At, B0); PG8_BAR; PG8_SCHED;
            PG8_STAGE(PG8_SB(1, 1), b3 + hstep, voffB);
            PG8_WAIT_V(6); PG8_BAR; PG8_MMA(1, 1, At, B1); PG8_BAR;
            }
        }
        if constexpr (ALIGN_EPI) { if (wr == 0) PG8_BAR; }
        if constexpr (PRESTAGE) { PG8_SCHED; { unsigned vp_[2][2] = {{voffA[0], voffA[1]}, {voffA[0], voffA[1]}}; PG8_GATHER(vp_, ui + 1); PG8_STAGE(PG8_SA(1, 1), nA + kstep + ahs, vp_[1]); } PG8_SCHED; }
        { int lane_e; asm volatile("v_mbcnt_lo_u32_b32 %0, -1, 0\n\tv_mbcnt_hi_u32_b32 %0, -1, %0" : "=v"(lane_e)); int fr_e = lane_e & 15, fq_e = lane_e >> 4;
          Unit ue = cur; asm volatile("" : "+s"(ue.pm), "+s"(ue.pn));
          run_epi(acc, ue, wr, wc, fr_e, fq_e, E); } S.done(cur);
        if (!has_next) break;
#pragma unroll
        for (int a = 0; a < 2; ++a)
#pragma unroll
            for (int b = 0; b < 2; ++b)
#pragma unroll
                for (int m = 0; m < 4; ++m)
#pragma unroll
                    for (int n = 0; n < 2; ++n) acc[a][b][m][n] = (f32x4){0.f, 0.f, 0.f, 0.f};
        cur = nxt; cA = nA; cB = nB; ++ui;
#pragma unroll
        for (int h_ = 0; h_ < 2; ++h_)
#pragma unroll
            for (int i_ = 0; i_ < 2; ++i_) voC[h_][i_] = voffA[i_];
        PG8_GATHER(voC, ui);
        if constexpr (ALIGN_EPI) { if (wr == 1) PG8_BAR; }
    }
    PG8_WAIT_V(0);
    if constexpr (!ALIGN_EPI) { if (wr == 0) PG8_BAR; }
    PG8_BAR;
#undef PG8_GATHER
#undef PG8_WAIT_VR
#undef PG8_SA
#undef PG8_SB
#undef PG8_STAGE
#undef PG8_LDA
#undef PG8_LDB
#undef PG8_MMA
#undef PG8_WAIT_V
#undef PG8_WAIT_L
#undef PG8_BAR
#undef PG8_SCHED
}
}


#ifndef GEMM_NAIVE
#define GEMM_NAIVE 0
#endif
template <class Epi>
__device__ __forceinline__ void gemm_run(Ctx& F, const GemmDesc g, const Epi& E) {
#if GEMM_NAIVE
    gemm_naive(F, g, E);
#else
    pg8::Gemm pg{g.A, g.Bt, g.K, g.tile_e, g.estride, g.gather}; pg8::StaticOrder S; S.init(g.nM, g.nN, F.nblk, F.blk);
    pg8::gemm_phase<Epi, pg8::StaticOrder, true, true>(F.lds, pg, S, E, F.tid);
    __syncthreads();
#endif
}
__device__ __forceinline__ void load_vec64(const bf16_t* p, float* v) {
#pragma unroll
    for (int j = 0; j < 8; ++j) unpack8(*(const u32x4*)(p + 8 * j), v + 8 * j);
}
__device__ __forceinline__ float dot64(const float* q, const bf16_t* kp) {
    float s = 0.f;
#pragma unroll
    for (int j = 0; j < 8; ++j) { float k[8]; unpack8(*(const u32x4*)(kp + 8 * j), k);
#pragma unroll
        for (int i = 0; i < 8; ++i) s += q[8 * j + i] * k[i]; }
    return s;
}
__device__ __forceinline__ void axpy64(float* o, float al, float p, const bf16_t* vp) {
#pragma unroll
    for (int j = 0; j < 8; ++j) { float v[8]; unpack8(*(const u32x4*)(vp + 8 * j), v);
#pragma unroll
        for (int i = 0; i < 8; ++i) o[8 * j + i] = o[8 * j + i] * al + p * v[i]; }
}
__device__ __forceinline__ void attend(const float* q, float* o, float& m, float& l, const bf16_t* kp, const bf16_t* vp, float bias) {
    const float s = bias + dot64(q, kp);
    const float mn = fmaxf(m, s), al = exp2f(m - mn), p = exp2f(s - mn); l = l * al + p; m = mn;
    axpy64(o, al, p, vp);
}
__device__ __forceinline__ void store_vec64_scaled(bf16_t* p, const float* o, float sc) {
#pragma unroll
    for (int j = 0; j < 8; ++j) { float t[8];
#pragma unroll
        for (int i = 0; i < 8; ++i) t[i] = o[8 * j + i] * sc;
        store8_bf16(p + 8 * j, t); }
}
__device__ __forceinline__ void naive_retention(Ctx& F) {
    const bf16_t* QKV = (const bf16_t*)(F.ws + WS_QKV); bf16_t* MIX = (bf16_t*)(F.ws + WS_MIX);
    const int total = NB * 8 * 2304;
    for (int idx = F.blk * NTHREADS + F.tid; idx < total; idx += F.nblk * NTHREADS) {
        const int n = idx % 2304, bh = idx / 2304, h = bh & 7, b = bh >> 3;
        const float df = F.in[I_RETDEC][h], db = F.in[I_RETDEC][8 + h];
        const float lgf = log1pf(-exp2f(-df)) * LOG2E, lgb = log1pf(-exp2f(-db)) * LOG2E;
        const size_t rowc = (size_t)NL + b * CTXL, rowl = (size_t)b * SEQ;
        const size_t myrow = n < 256 ? rowc + n : rowl + (n - 256);
        float q[64], o[64]; load_vec64(QKV + myrow * ABIN + h * 64, q);
#pragma unroll
        for (int i = 0; i < 64; ++i) o[i] = 0.f;
        for (int m = 0; m < 2304; ++m) {
            float w = 0.f;
            if (n < 256) { if (m < 256) { if (m <= n) w += exp2f(lgf * (float)(n - m)); if (m >= n) w += exp2f(lgb * (float)(m - n)); } else continue; }
            else { const int t = n - 256;
                if (m < 256) w = exp2f(lgf * (float)(n - m)) + exp2f(lgb * (float)(2048 - t + m));
                else { const int t2 = m - 256; if (t2 <= t) w += exp2f(lgf * (float)(t - t2)); if (t2 >= t) w += exp2f(lgb * (float)(t2 - t)); } }
            const size_t r = m < 256 ? rowc + m : rowl + (m - 256);
            const float s = w * dot64(q, QKV + r * ABIN + 512 + h * 64);
            axpy64(o, 1.f, s, QKV + r * ABIN + 1024 + h * 64);
        }
        float mu = 0.f;
#pragma unroll
        for (int i = 0; i < 64; ++i) mu += o[i];
        mu *= (1.f / 64.f); float var = 0.f;
#pragma unroll
        for (int i = 0; i < 64; ++i) { o[i] -= mu; var += o[i] * o[i]; }
        const float rs = rsqrtf(var * (1.f / 64.f) + 1e-5f);
#pragma unroll
        for (int j = 0; j < 8; ++j) { float g[8], t[8]; unpack8(*(const u32x4*)(QKV + myrow * ABIN + 1536 + h * 64 + 8 * j), g);
#pragma unroll
            for (int i = 0; i < 8; ++i) t[i] = o[8 * j + i] * rs * F.in[I_RETGN][h * 64 + 8 * j + i] * silu_f(g[i]);
            store8_bf16(MIX + myrow * D + h * 64 + 8 * j, t); }
    }
}
__device__ __forceinline__ void naive_na(Ctx& F) {
    const bf16_t* QKV = (const bf16_t*)(F.ws + WS_QKV); bf16_t* MIX = (bf16_t*)(F.ws + WS_MIX);
    const int total = NB * 8 * 2304;
    for (int idx = F.blk * NTHREADS + F.tid; idx < total; idx += F.nblk * NTHREADS) {
        const int n = idx % 2304, bh = idx / 2304, h = bh & 7, b = bh >> 3;
        const size_t rowc = (size_t)NL + b * CTXL, rowl = (size_t)b * SEQ;
        const size_t myrow = n < 2048 ? rowl + n : rowc + (n - 2048);
        float q[64], o[64]; load_vec64(QKV + myrow * ABIN + 2048 + h * 64, q);
#pragma unroll
        for (int i = 0; i < 64; ++i) o[i] = 0.f;
        float m = -1e30f, l = 0.f;
        if (n < 2048) { const int r = n >> 6, c = n & 63; int rs = r - 4; rs = rs < 0 ? 0 : (rs > 24 ? 24 : rs); int win = c - 8; win = win < 0 ? 0 : (win > 48 ? 48 : win);
            const float* rpb = F.in[I_RPB] + (size_t)h * 15 * 31;
            for (int i = 0; i < 8; ++i) for (int j = 0; j < 16; ++j) { const int kr = rs + i, kc = win + j; const size_t kro = rowl + kr * 64 + kc;
                attend(q, o, m, l, QKV + kro * ABIN + 2560 + h * 64, QKV + kro * ABIN + 3072 + h * 64, rpb[(kr - r + 7) * 31 + (kc - c + 15)] * LOG2E); } }
        for (int j = 0; j < 256; ++j) { const size_t kro = rowc + j; attend(q, o, m, l, QKV + kro * ABIN + 2560 + h * 64, QKV + kro * ABIN + 3072 + h * 64, 0.f); }
        store_vec64_scaled(MIX + myrow * D + 512 + h * 64, o, 1.f / l);
    }
}
__device__ __forceinline__ void naive_swa(Ctx& F) {
    const bf16_t* QKV = (const bf16_t*)(F.ws + WS_QKV); bf16_t* MIX = (bf16_t*)(F.ws + WS_MIX);
    const int total = NB * 16 * 2048;
    for (int idx = F.blk * NTHREADS + F.tid; idx < total; idx += F.nblk * NTHREADS) {
        const int t = idx & 2047, bh = idx >> 11, h = bh & 15, b = bh >> 4, kv = h >> 2;
        const size_t rowc = (size_t)NL + b * CTXL, rowl = (size_t)b * SEQ;
        float q[64], o[64]; load_vec64(QKV + (rowl + t) * SWAIN + h * 64, q);
#pragma unroll
        for (int i = 0; i < 64; ++i) o[i] = 0.f;
        float m = F.in[I_SINK][h] * LOG2E, l = 1.f;
        const int lo = t - 128 < 0 ? 0 : t - 128, hi = t + 128 > 2047 ? 2047 : t + 128;
        for (int j = lo; j <= hi; ++j) attend(q, o, m, l, QKV + (rowl + j) * SWAIN + 1024 + kv * 64, QKV + (rowl + j) * SWAIN + 1280 + kv * 64, 0.f);
        for (int j = 0; j < 256; ++j) attend(q, o, m, l, QKV + (rowc + j) * SWAIN + 1024 + kv * 64, QKV + (rowc + j) * SWAIN + 1280 + kv * 64, 0.f);
        store_vec64_scaled(MIX + (rowl + t) * D + h * 64, o, 1.f / l);
    }
}


typedef float f32x16 __attribute__((ext_vector_type(16)));
typedef short s16x4 __attribute__((ext_vector_type(4)));
__device__ __forceinline__ int crow(int r, int hi) { return (r & 3) + 8 * (r >> 2) + 4 * hi; }
__device__ __forceinline__ s16x4 vtr(const LAS char* p) { return __builtin_bit_cast(s16x4, __builtin_amdgcn_ds_read_tr16_b64_v4i16((LAS s16x4*)p)); }
__device__ __forceinline__ unsigned cvtpk(float lo, float hi) { typedef float f2 __attribute__((ext_vector_type(2))); typedef __bf16 b2 __attribute__((ext_vector_type(2)));
    f2 v = {lo, hi}; b2 b = __builtin_convertvector(v, b2); return __builtin_bit_cast(unsigned, b); }
__device__ __forceinline__ float swapmax(float v) { auto rr = __builtin_amdgcn_permlane32_swap(__float_as_uint(v), __float_as_uint(v), false, false); return fmaxf(__uint_as_float(rr[0]), __uint_as_float(rr[1])); }
__device__ __forceinline__ float swapsum(float v) { auto rr = __builtin_amdgcn_permlane32_swap(__float_as_uint(v), __float_as_uint(v), false, false); return __uint_as_float(rr[0]) + __uint_as_float(rr[1]); }
constexpr int FA_WAVE_LDS = 15104;
constexpr int FA_V = 8192, FA_SCR = 12288, FA_BIAS = 12544;

struct FaTile { unsigned k; int mode, p0, p1, p2; };
__device__ __forceinline__ void fa_uniform(FaTile& T) { T.k = __builtin_amdgcn_readfirstlane(T.k); T.mode = __builtin_amdgcn_readfirstlane(T.mode); T.p0 = __builtin_amdgcn_readfirstlane(T.p0); T.p1 = __builtin_amdgcn_readfirstlane(T.p1); T.p2 = __builtin_amdgcn_readfirstlane(T.p2); }
struct FaAcc { f32x16 o[2][2]; float m[2], l[2]; };

__device__ __forceinline__ void fa_load_k(const bf16_t* base, const FaTile& T, int ld, int lane, bf16x8* kf) {
    const int r32 = lane & 31, hi = lane >> 5; const bf16_t* p = base + T.k;
#pragma unroll
    for (int ds = 0; ds < 4; ++ds) kf[ds] = *(const bf16x8*)(p + (unsigned)(r32 * ld + 16 * ds + 8 * hi));
}
__device__ __forceinline__ void fa_load_v(const bf16_t* base, const FaTile& T, int ld, int lane, u32x4* vr) {
    const bf16_t* p = base + T.k;
#pragma unroll
    for (int i = 0; i < 4; ++i) { const int c = lane + 64 * i; vr[i] = *(const u32x4*)(p + (unsigned)((c >> 3) * ld + (c & 7) * 8)); }
}
__device__ __forceinline__ void fa_tile(const FaTile& T, const bf16x8* kf, const u32x4* vr, FaAcc& A, LAS char* wl, int lane) {
    const int r32 = lane & 31, hi = lane >> 5;
    LAS float* scr = (LAS float*)(wl + FA_SCR); const LAS float* bias = (const LAS float*)(wl + FA_BIAS);
    bf16x8 pf[2][2];
#pragma unroll
    for (int qb = 0; qb < 2; ++qb) {
        f32x16 sc = f32x16{};
#pragma unroll
        for (int ds = 0; ds < 4; ++ds) { const bf16x8 qf = *(const LAS bf16x8*)(wl + (qb * 4 + ds) * 1024 + lane * 16); sc = __builtin_amdgcn_mfma_f32_32x32x16_bf16(kf[ds], qf, sc, 0, 0, 0); }
        if (T.mode == 1) {
            const int qr = T.p2 + 2 * qb + (r32 >> 4), c = T.p1 + (r32 & 15); int ks = T.p1 - 8; ks = ks < 0 ? 0 : (ks > 32 ? 32 : ks);
            int win = c - 8; win = win < 0 ? 0 : (win > 48 ? 48 : win); int rsq = qr - 4; rsq = rsq < 0 ? 0 : (rsq > 24 ? 24 : rsq);
            const bool rowok = (unsigned)(T.p0 - rsq) < 8u;
            const int lb = ks + 4 * hi - c + 15, vb = lb - (win - c + 15);
            const LAS float* bp = bias + 48 + (T.p0 - qr + 7) * 31 + lb;
#pragma unroll
            for (int r = 0; r < 16; ++r) { const int cr = (r & 3) + 8 * (r >> 2); const bool ok = rowok && (unsigned)(vb + cr) < 16u; const float bv = bp[cr]; sc[r] = ok ? sc[r] + bv : -INFINITY; }
        } else if (T.mode == 2) { const int base = T.p0 - (32 * qb + r32);
#pragma unroll
            for (int r = 0; r < 16; ++r) { const int d = base + crow(r, hi); if (d > 128 || d < -128) sc[r] = -INFINITY; }
        }
        float tm = sc[0];
#pragma unroll
        for (int r = 1; r < 16; ++r) tm = fmaxf(tm, sc[r]);
        tm = swapmax(tm);
        if (__any(tm > A.m[qb] + 8.f)) {
            const float mn = fmaxf(A.m[qb], tm), al = __builtin_amdgcn_exp2f(A.m[qb] - mn); A.m[qb] = mn; A.l[qb] *= al;
            if (hi == 0) scr[32 * qb + r32] = al;
#pragma unroll
            for (int r = 0; r < 16; ++r) { const float f = scr[32 * qb + crow(r, hi)]; A.o[qb][0][r] *= f; A.o[qb][1][r] *= f; }
        }
        float ps = 0.f; const float mm = A.m[qb];
#pragma unroll
        for (int r = 0; r < 16; ++r) { const float p = __builtin_amdgcn_exp2f(sc[r] - mm); sc[r] = p; ps += p; }
        A.l[qb] += ps;
#pragma unroll
        for (int s2 = 0; s2 < 2; ++s2) { u32x4 w; w.x = cvtpk(sc[8 * s2], sc[8 * s2 + 1]); w.y = cvtpk(sc[8 * s2 + 2], sc[8 * s2 + 3]);
            w.z = cvtpk(sc[8 * s2 + 4], sc[8 * s2 + 5]); w.w = cvtpk(sc[8 * s2 + 6], sc[8 * s2 + 7]); pf[qb][s2] = __builtin_bit_cast(bf16x8, w); }
    }
#pragma unroll
    for (int i = 0; i < 4; ++i) { const int c = lane + 64 * i, key = c >> 3, pc = c & 7; *(LAS u32x4*)(wl + FA_V + (pc >> 2) * 2048 + key * 64 + (pc & 3) * 16) = vr[i]; }
    const LAS char* vb = wl + FA_V + (4 * hi + ((lane & 15) >> 2)) * 64 + (16 * ((lane >> 4) & 1) + 4 * (lane & 3)) * 2;
#pragma unroll
    for (int nb = 0; nb < 2; ++nb)
#pragma unroll
        for (int s2 = 0; s2 < 2; ++s2) { const s16x4 lo = vtr(vb + nb * 2048 + s2 * 1024), hh = vtr(vb + nb * 2048 + s2 * 1024 + 512);
            const bf16x8 vf = {lo[0], lo[1], lo[2], lo[3], hh[0], hh[1], hh[2], hh[3]};
            A.o[0][nb] = __builtin_amdgcn_mfma_f32_32x32x16_bf16(pf[0][s2], vf, A.o[0][nb], 0, 0, 0);
            A.o[1][nb] = __builtin_amdgcn_mfma_f32_32x32x16_bf16(pf[1][s2], vf, A.o[1][nb], 0, 0, 0); }
}
template <class TL, class RM>
__device__ __forceinline__ void fa_unit(const TL& tl, const RM& rm, int nt, const bf16_t* q, int ldq, const bf16_t* kbase, const bf16_t* vbase, int ldkv, bf16_t* out, int ldo, float m0, float l0, LAS char* wl, int lane_in) {
    int lane = lane_in; asm volatile("" : "+v"(lane));
    int r32 = lane & 31, hi = lane >> 5;
#pragma unroll
    for (int qb = 0; qb < 2; ++qb)
#pragma unroll
        for (int ds = 0; ds < 4; ++ds) { const bf16x8 qf = *(const bf16x8*)(q + (size_t)rm(qb, r32) * ldq + 16 * ds + 8 * hi); *(LAS bf16x8*)(wl + (qb * 4 + ds) * 1024 + lane * 16) = qf; }
    FaAcc A;
#pragma unroll
    for (int qb = 0; qb < 2; ++qb) { A.o[qb][0] = f32x16{}; A.o[qb][1] = f32x16{}; A.m[qb] = m0; A.l[qb] = hi == 0 ? l0 : 0.f; }
    FaTile T, Tn; bf16x8 kf[4], kn[4]; u32x4 vr[4];
    tl(0, T); fa_uniform(T); fa_load_k(kbase, T, ldkv, lane, kf);
    for (int t = 0; t < nt; ++t) {
        fa_load_v(vbase, T, ldkv, lane, vr);
        tl(t + 1 < nt ? t + 1 : t, Tn); fa_uniform(Tn); fa_load_k(kbase, Tn, ldkv, lane, kn);
        fa_tile(T, kf, vr, A, wl, lane);
        T = Tn;
#pragma unroll
        for (int i = 0; i < 4; ++i) kf[i] = kn[i];
    }
    asm volatile("" : "+v"(lane)); r32 = lane & 31; hi = lane >> 5;
    LAS float* scr = (LAS float*)(wl + FA_SCR); LAS bf16_t* stg = (LAS bf16_t*)wl;
#pragma unroll
    for (int qb = 0; qb < 2; ++qb) { const float lt = swapsum(A.l[qb]); if (hi == 0) scr[32 * qb + r32] = 1.f / lt; }
    asm volatile("s_waitcnt lgkmcnt(0)" ::: "memory");
#pragma unroll
    for (int qb = 0; qb < 2; ++qb)
#pragma unroll
        for (int r = 0; r < 16; ++r) { const int row = 32 * qb + crow(r, hi); const float f = scr[row];
            stg[row * 64 + r32] = (bf16_t)f2bf(A.o[qb][0][r] * f); stg[row * 64 + 32 + r32] = (bf16_t)f2bf(A.o[qb][1][r] * f); }
    asm volatile("s_waitcnt lgkmcnt(0)" ::: "memory");
#pragma unroll
    for (int it = 0; it < 8; ++it) { const int row = it * 8 + (lane >> 3), ch = lane & 7; const u32x4 v = *(const LAS u32x4*)(wl + row * 128 + ch * 16); *(u32x4*)(out + (size_t)rm(row >> 5, row & 31) * ldo + ch * 8) = v; }
    asm volatile("s_waitcnt lgkmcnt(0)" ::: "memory");
}

struct RowSeq { __device__ __forceinline__ int operator()(int qb, int r32) const { return 32 * qb + r32; } };
struct RowQuad { int c0; __device__ __forceinline__ int operator()(int qb, int r32) const { return (2 * qb + (r32 >> 4)) * 64 + c0 + (r32 & 15); } };
struct NaTiles { unsigned kl, kc; int kr0, nloc, c0, R0;
    __device__ __forceinline__ void operator()(int t, FaTile& T) const {
        if (t < nloc) { int ks = c0 - 8; ks = ks < 0 ? 0 : (ks > 32 ? 32 : ks); T.k = kl + (unsigned)((kr0 + t) * 64 + ks) * ABIN; T.mode = 1; T.p0 = kr0 + t; T.p1 = c0; T.p2 = R0; }
        else { T.k = kc + (unsigned)(32 * (t - nloc)) * ABIN; T.mode = 0; T.p0 = 0; T.p1 = 0; T.p2 = 0; } } };
struct CtxTiles { unsigned kc; int ld;
    __device__ __forceinline__ void operator()(int t, FaTile& T) const { T.k = kc + (unsigned)(32 * t) * ld; T.mode = 0; T.p0 = 0; T.p1 = 0; T.p2 = 0; } };
__device__ __forceinline__ void na_unit(Ctx& F, int u, LAS char* wl) {
    const bf16_t* QKV = (const bf16_t*)(F.ws + WS_QKV); bf16_t* MIX = (bf16_t*)(F.ws + WS_MIX);
    if (u < 4096) { const int j = u & 3, Rq = (u >> 2) & 7, bh = u >> 5, h = bh & 7, b = bh >> 3, R0 = 4 * Rq, c0 = 16 * j;
        LAS float* bias = (LAS float*)(wl + FA_BIAS); const float* rpb = F.in[I_RPB] + (size_t)h * 465;
        for (int i = F.lane; i < 465; i += 64) bias[48 + i] = rpb[i] * LOG2E;
        asm volatile("s_waitcnt lgkmcnt(0)" ::: "memory");
        int kr0 = R0 - 4; kr0 = kr0 < 0 ? 0 : (kr0 > 24 ? 24 : kr0); int rl = R0 + 3 - 4; rl = rl < 0 ? 0 : (rl > 24 ? 24 : rl); const int nloc = rl + 7 - kr0 + 1;
        const size_t rowl = (size_t)b * SEQ, rowc = (size_t)NL + b * CTXL;
        NaTiles tl{(unsigned)(rowl * ABIN + 2560 + h * 64), (unsigned)(rowc * ABIN + 2560 + h * 64), kr0, nloc, c0, R0};
        fa_unit(tl, RowQuad{c0}, nloc + 8, QKV + (rowl + R0 * 64) * ABIN + 2048 + h * 64, ABIN, QKV, QKV + 512, ABIN, MIX + (rowl + R0 * 64) * D + 512 + h * 64, D, -1e30f, 0.f, wl, F.lane);
    } else { const int v = u - 4096, qb = v & 3, bh = v >> 2, h = bh & 7, b = bh >> 3; const size_t rowc = (size_t)NL + b * CTXL;
        CtxTiles tl{(unsigned)(rowc * ABIN + 2560 + h * 64), ABIN};
        fa_unit(tl, RowSeq{}, 8, QKV + (rowc + qb * 64) * ABIN + 2048 + h * 64, ABIN, QKV, QKV + 512, ABIN, MIX + (rowc + qb * 64) * D + 512 + h * 64, D, -1e30f, 0.f, wl, F.lane);
    }
}
struct SwaTiles { unsigned kl, kc; int t0, first, nloc;
    __device__ __forceinline__ void operator()(int t, FaTile& T) const {
        if (t < nloc) { const int ks = first + 32 * t; T.k = kl + (unsigned)ks * SWAIN; const bool inner = (ks >= t0 - 65) && (ks + 31 <= t0 + 128); T.mode = inner ? 0 : 2; T.p0 = ks - t0; T.p1 = 0; T.p2 = 0; }
        else { T.k = kc + (unsigned)(32 * (t - nloc)) * SWAIN; T.mode = 0; T.p0 = 0; T.p1 = 0; T.p2 = 0; } } };
__device__ __forceinline__ void swa_unit(Ctx& F, int u, LAS char* wl) {
    const bf16_t* QKV = (const bf16_t*)(F.ws + WS_QKV); bf16_t* MIX = (bf16_t*)(F.ws + WS_MIX);
    const int g = u & 3, qblk = (u >> 2) & 31, kv = (u >> 7) & 3, b = u >> 9, h = kv * 4 + g, t0 = qblk * 64;
    const size_t rowl = (size_t)b * SEQ, rowc = (size_t)NL + b * CTXL;
    int lo = t0 - 128; lo = lo < 0 ? 0 : lo; int hi = t0 + 192; hi = hi > SEQ ? SEQ : hi;
    SwaTiles tl{(unsigned)(rowl * SWAIN + 1024 + kv * 64), (unsigned)(rowc * SWAIN + 1024 + kv * 64), t0, lo, (hi - lo) >> 5};
    fa_unit(tl, RowSeq{}, tl.nloc + 8, QKV + (rowl + t0) * SWAIN + h * 64, SWAIN, QKV, QKV + 256, SWAIN, MIX + (rowl + t0) * D + h * 64, D, F.in[I_SINK][h] * LOG2E, 1.f, wl, F.lane);
}
__device__ __forceinline__ void phase_na(Ctx& F) {
    LAS char* wl = (LAS char*)F.lds + F.wave * FA_WAVE_LDS;
    unsigned* q = (unsigned*)(F.ws + WS_CTL) + 16;
    for (;;) { unsigned u = 0; if (F.lane == 0) u = atomicAdd(q, 1u); u = __builtin_amdgcn_readfirstlane(u); if (u >= 4096u + 512u) break; na_unit(F, (int)u, wl); }
}
__device__ __forceinline__ void phase_swa(Ctx& F) {
    LAS char* wl = (LAS char*)F.lds + F.wave * FA_WAVE_LDS;
    for (int u = F.blk * NWAVES + F.wave; u < 8192; u += F.nblk * NWAVES) swa_unit(F, u, wl);
}

constexpr size_t WS_SB = WS_Y;
__device__ __forceinline__ bf16x8 trfrag_nat(const LAS char* base) {
    const s16x4 lo = vtr(base), hh = vtr(base + 256); return (bf16x8){lo[0], lo[1], lo[2], lo[3], hh[0], hh[1], hh[2], hh[3]}; }
__device__ __forceinline__ bf16x8 trfrag_acc(const LAS char* base) {
    const s16x4 lo = vtr(base), hh = vtr(base + 512); return (bf16x8){lo[0], lo[1], lo[2], lo[3], hh[0], hh[1], hh[2], hh[3]}; }
__device__ __forceinline__ u32x4 scale8(const u32x4 w, float f) { float t[8]; unpack8(w, t); u32x4 o; o.x = pk2(t[0] * f, t[1] * f); o.y = pk2(t[2] * f, t[3] * f); o.z = pk2(t[4] * f, t[5] * f); o.w = pk2(t[6] * f, t[7] * f); return o; }

__device__ __forceinline__ void ret_unit(Ctx& F, int bh) {
    const int b = bh >> 3, h = bh & 7;
    int lane = F.lane; asm volatile("" : "+v"(lane));
    const int wave = F.wave, r32 = lane & 31, hi = lane >> 5, grp = wave >> 2, wq = wave & 3, t4 = (wave & 3) * 64 + lane;
    const float lgf = log1pf(-exp2f(-F.in[I_RETDEC][h])) * LOG2E, lgb = log1pf(-exp2f(-F.in[I_RETDEC][8 + h])) * LOG2E;
    const bf16_t* QKV = (const bf16_t*)(F.ws + WS_QKV); bf16_t* MIX = (bf16_t*)(F.ws + WS_MIX);
    const size_t rowl = (size_t)b * SEQ, rowc = (size_t)NL + b * CTXL;
    bf16_t* SB = (bf16_t*)(F.ws + WS_SB) + (size_t)bh * 2 * 18 * 4096;
    LAS char* L = (LAS char*)F.lds;
    const int trq = (lane & 15) >> 2, trp = lane & 3, trg = (lane >> 4) & 1;
    const int troff = trq * 64 + (16 * trg + 4 * trp) * 2;
    LAS float* gnl = (LAS float*)(L + 135168);
    if (F.tid < 64) gnl[F.tid] = F.in[I_RETGN][h * 64 + F.tid];
    {
        LAS char* Kd = L + grp * 32768; LAS char* Vt = Kd + 16384;
        const float lg = grp ? lgb : lgf, g128 = __builtin_amdgcn_exp2f(lg * 128.f);
        const int dkb = wq >> 1, dvb = wq & 1;
        f32x16 st = f32x16{};
        for (int i = 0; i < 18; ++i) {
            const int seq = grp ? (i < 2 ? 1 - i : 19 - i) : i;
            { bf16_t* sp = SB + (size_t)(grp * 18 + seq) * 4096;
#pragma unroll
              for (int r = 0; r < 16; ++r) sp[(32 * dkb + crow(r, hi)) * 64 + 32 * dvb + r32] = (bf16_t)f2bf(st[r]); }
            if (i == 17) break;
            const size_t row0 = seq < 2 ? rowc + 128 * seq : rowl + 128 * (seq - 2);
#pragma unroll
            for (int j = 0; j < 4; ++j) { const int p = t4 + 256 * j, row = p >> 3, pc = p & 7;
                const u32x4 kv = *(const u32x4*)(QKV + (row0 + row) * ABIN + 512 + h * 64 + pc * 8), vv = *(const u32x4*)(QKV + (row0 + row) * ABIN + 1024 + h * 64 + pc * 8);
                const float dec = __builtin_amdgcn_exp2f(lg * (float)(grp ? row : 127 - row));
                const int off = (pc >> 2) * 8192 + row * 64 + (pc & 3) * 16;
                *(LAS u32x4*)(Kd + off) = scale8(kv, dec); *(LAS u32x4*)(Vt + off) = vv; }
            asm volatile("s_waitcnt lgkmcnt(0)" ::: "memory"); __syncthreads();
#pragma unroll
            for (int r = 0; r < 16; ++r) st[r] *= g128;
#pragma unroll
            for (int s2 = 0; s2 < 8; ++s2) { const int ro = (16 * s2 + 8 * hi) * 64 + troff;
                const bf16x8 af = trfrag_nat(Kd + dkb * 8192 + ro), bf = trfrag_nat(Vt + dvb * 8192 + ro);
                st = __builtin_amdgcn_mfma_f32_32x32x16_bf16(af, bf, st, 0, 0, 0); }
            asm volatile("s_waitcnt lgkmcnt(0)" ::: "memory"); __syncthreads();
        }
    }
    asm volatile("s_waitcnt vmcnt(0)" ::: "memory"); __syncthreads();
    for (int rd = 0; rd < 9; ++rd) {
        const int seq = 2 * rd + grp;
        const size_t row0 = seq < 2 ? rowc + 128 * seq : rowl + 128 * (seq - 2);
        LAS char* Vt = L + grp * 16384; LAS char* Sf = L + 32768 + grp * 16384; LAS char* Sbk = Sf + 8192;
#pragma unroll
        for (int j = 0; j < 4; ++j) { const int p = t4 + 256 * j, row = p >> 3, pc = p & 7;
            *(LAS u32x4*)(Vt + (pc >> 2) * 8192 + row * 64 + (pc & 3) * 16) = *(const u32x4*)(QKV + (row0 + row) * ABIN + 1024 + h * 64 + pc * 8); }
#pragma unroll
        for (int j = 0; j < 4; ++j) { const int p = t4 + 256 * j, d = j >> 1, pp = p & 511, row = pp >> 3, pc = pp & 7;
            *(LAS u32x4*)((d ? Sbk : Sf) + (pc >> 2) * 4096 + row * 64 + (pc & 3) * 16) = *(const u32x4*)(SB + (size_t)(d * 18 + seq) * 4096 + row * 64 + pc * 8); }
        bf16x8 qf[4], kfa[4][4];
#pragma unroll
        for (int ds = 0; ds < 4; ++ds) qf[ds] = *(const bf16x8*)(QKV + (row0 + 32 * wq + r32) * ABIN + h * 64 + 16 * ds + 8 * hi);
#pragma unroll
        for (int kb = 0; kb < 4; ++kb)
#pragma unroll
            for (int ds = 0; ds < 4; ++ds) kfa[kb][ds] = *(const bf16x8*)(QKV + (row0 + 32 * kb + r32) * ABIN + 512 + h * 64 + 16 * ds + 8 * hi);
        asm volatile("s_waitcnt lgkmcnt(0)" ::: "memory"); __syncthreads();
        f32x16 oi[2], of[2], ob[2];
#pragma unroll
        for (int nb = 0; nb < 2; ++nb) { oi[nb] = f32x16{}; of[nb] = f32x16{}; ob[nb] = f32x16{}; }
        const int nq = 32 * wq + r32;
#pragma unroll
        for (int kb = 0; kb < 4; ++kb) {
            f32x16 sc = f32x16{};
#pragma unroll
            for (int ds = 0; ds < 4; ++ds) sc = __builtin_amdgcn_mfma_f32_32x32x16_bf16(kfa[kb][ds], qf[ds], sc, 0, 0, 0);
#pragma unroll
            for (int r = 0; r < 16; ++r) { const int d = nq - (32 * kb + crow(r, hi)); const float e = __builtin_amdgcn_exp2f((d > 0 ? lgf : -lgb) * (float)d); sc[r] *= (d == 0 ? 2.f : e); }
#pragma unroll
            for (int s2 = 0; s2 < 2; ++s2) { u32x4 w; w.x = cvtpk(sc[8 * s2], sc[8 * s2 + 1]); w.y = cvtpk(sc[8 * s2 + 2], sc[8 * s2 + 3]); w.z = cvtpk(sc[8 * s2 + 4], sc[8 * s2 + 5]); w.w = cvtpk(sc[8 * s2 + 6], sc[8 * s2 + 7]);
                const bf16x8 pf = __builtin_bit_cast(bf16x8, w);
#pragma unroll
                for (int nb = 0; nb < 2; ++nb) { const bf16x8 vf = trfrag_acc(Vt + nb * 8192 + (32 * kb + 16 * s2 + 4 * hi) * 64 + troff);
                    oi[nb] = __builtin_amdgcn_mfma_f32_32x32x16_bf16(pf, vf, oi[nb], 0, 0, 0); } }
        }
#pragma unroll
        for (int nb = 0; nb < 2; ++nb)
#pragma unroll
            for (int s2 = 0; s2 < 4; ++s2) { const int ro = nb * 4096 + (16 * s2 + 8 * hi) * 64 + troff;
                of[nb] = __builtin_amdgcn_mfma_f32_32x32x16_bf16(qf[s2], trfrag_nat(Sf + ro), of[nb], 0, 0, 0);
                ob[nb] = __builtin_amdgcn_mfma_f32_32x32x16_bf16(qf[s2], trfrag_nat(Sbk + ro), ob[nb], 0, 0, 0); }
        LAS float* stg = (LAS float*)(L + 65536 + wave * 8704);
#pragma unroll
        for (int r = 0; r < 16; ++r) { const int n = 32 * wq + crow(r, hi); const float sf = __builtin_amdgcn_exp2f(lgf * (float)(n + 1)), sb = __builtin_amdgcn_exp2f(lgb * (float)(128 - n));
            stg[crow(r, hi) * 68 + r32] = oi[0][r] + sf * of[0][r] + sb * ob[0][r]; stg[crow(r, hi) * 68 + 32 + r32] = oi[1][r] + sf * of[1][r] + sb * ob[1][r]; }
        asm volatile("s_waitcnt lgkmcnt(0)" ::: "memory");
        { float v[32]; float sm = 0.f;
#pragma unroll
          for (int c4 = 0; c4 < 8; ++c4) { const f32x4 t = *(const LAS f32x4*)(stg + r32 * 68 + 32 * hi + 4 * c4); v[4 * c4] = t[0]; v[4 * c4 + 1] = t[1]; v[4 * c4 + 2] = t[2]; v[4 * c4 + 3] = t[3]; sm += (t[0] + t[1]) + (t[2] + t[3]); }
          const float mu = swapsum(sm) * (1.f / 64.f); float vs = 0.f;
#pragma unroll
          for (int i = 0; i < 32; ++i) { v[i] -= mu; vs += v[i] * v[i]; }
          const float rs = rsqrtf(swapsum(vs) * (1.f / 64.f) + 1e-5f);
          const size_t row = row0 + 32 * wq + r32; const bf16_t* gp = QKV + row * ABIN + 1536 + h * 64 + 32 * hi; const LAS float* gn = gnl + 32 * hi; bf16_t* op = MIX + row * D + h * 64 + 32 * hi;
          u32x4 gw4[4];
#pragma unroll
          for (int c8 = 0; c8 < 4; ++c8) gw4[c8] = __builtin_nontemporal_load((const u32x4*)(gp + 8 * c8));
#pragma unroll
          for (int c8 = 0; c8 < 4; ++c8) { float g[8], t[8]; unpack8(gw4[c8], g);
#pragma unroll
              for (int i = 0; i < 8; ++i) t[i] = v[8 * c8 + i] * rs * gn[8 * c8 + i] * g[i] * __builtin_amdgcn_rcpf(1.f + __builtin_amdgcn_exp2f(-LOG2E * g[i]));
              store8_bf16(op + 8 * c8, t); } }
        asm volatile("s_waitcnt lgkmcnt(0)" ::: "memory"); __syncthreads();
    }
}
__device__ __forceinline__ void phase_ret(Ctx& F) {
    if (F.blk < 128) ret_unit(F, F.blk);
    __syncthreads();
}

#define XB_TMO      128
#define XB_XCNT(j)  (256  + 64 * (j))
#define XB_XSUB(j)  (1280 + 64 * (j))
#define XB_XGEN(j)  (2304 + 64 * (j))
#define XB_TOP      3328
#define XB_TOPGEN   3392
#define XCD_BAR_WORDS 3456
#define XB_SPIN_CAP (1u << 18)

__device__ __forceinline__ unsigned xb_ld(unsigned* p)              { return __hip_atomic_load(p, __ATOMIC_RELAXED, __HIP_MEMORY_SCOPE_AGENT); }
__device__ __forceinline__ unsigned xb_add(unsigned* p, unsigned v) { return __hip_atomic_fetch_add(p, v, __ATOMIC_RELAXED, __HIP_MEMORY_SCOPE_AGENT); }
__device__ __forceinline__ unsigned xb_xcc_id() { return (unsigned)__builtin_amdgcn_s_getreg((3 << 11) | 20) & 0xFu; }
#define XB_SPIN(cond, bar) do { unsigned _sp = 0; while (cond) { __builtin_amdgcn_s_sleep(1); \
    if ((++_sp & 255u) == 0u) { if (xb_ld(&(bar)[XB_TMO])) break; if (_sp > XB_SPIN_CAP) { atomicAdd(&(bar)[XB_TMO], 1u); break; } } } } while (0)

struct XcdBarrier {
    unsigned* bar; unsigned x;
    volatile LAS unsigned* st;
};

__device__ __forceinline__ XcdBarrier xcd_barrier_post(unsigned* bar, volatile LAS unsigned* st) {
    XcdBarrier b; b.bar = bar; b.x = xb_xcc_id(); b.st = st;
    if (threadIdx.x == 0) (void)xb_add(&bar[XB_XCNT(b.x)], 1u);
    return b;
}
__device__ __forceinline__ void xcd_barrier_complete(unsigned* bar, unsigned x, unsigned& nloc, unsigned& nx) {
    const unsigned G = gridDim.x * gridDim.y * gridDim.z;
    unsigned sum, cnt, mine, sp = 0u;
    for (;;) {
        sum = 0u; cnt = 0u; mine = 0u;
#pragma unroll
        for (unsigned j = 0; j < 16; ++j) { const unsigned c = xb_ld(&bar[XB_XCNT(j)]); sum += c; cnt += (c > 0u) ? 1u : 0u; mine = (j == x) ? c : mine; }
        if (sum == G) break;
        __builtin_amdgcn_s_sleep(1);
        if ((++sp & 255u) == 0u) { if (xb_ld(&bar[XB_TMO])) break; if (sp > XB_SPIN_CAP) { atomicAdd(&bar[XB_TMO], 1u); break; } }
    }
    nloc = mine > 0u ? mine : 1u; nx = cnt > 0u ? cnt : 1u;
}

__device__ __forceinline__ void xcd_barrier(const XcdBarrier& b, const bool leader) {
    asm volatile("s_waitcnt vmcnt(0)" ::: "memory");
    __syncthreads();
    if (leader) {
        unsigned* bar = b.bar;
        __builtin_amdgcn_s_waitcnt(0);
        unsigned nloc = b.st[0], nx = b.st[1];
        if (nloc == 0u) { xcd_barrier_complete(bar, b.x, nloc, nx); b.st[0] = nloc; b.st[1] = nx; }
        const unsigned old = xb_add(&bar[XB_XSUB(b.x)], 1u);
        const unsigned gen = old / nloc;
        if (old + 1u == (gen + 1u) * nloc) {
            __builtin_amdgcn_fence(__ATOMIC_RELEASE, "agent");
            asm volatile("s_waitcnt vmcnt(0)" ::: "memory");
            const unsigned og = xb_add(&bar[XB_TOP], 1u);
            const unsigned tg = og / nx;
            if (og + 1u == (tg + 1u) * nx) xb_add(&bar[XB_TOPGEN], 1u);
            else XB_SPIN(xb_ld(&bar[XB_TOPGEN]) == tg, bar);
            __builtin_amdgcn_fence(__ATOMIC_ACQUIRE, "agent");
            xb_add(&bar[XB_XGEN(b.x)], 1u);
            asm volatile("s_waitcnt vmcnt(0)" ::: "memory");
        } else {
            XB_SPIN(xb_ld(&bar[XB_XGEN(b.x)]) == gen, bar);
            __builtin_amdgcn_fence(__ATOMIC_ACQUIRE, "agent");
            asm volatile("s_waitcnt vmcnt(0)" ::: "memory");
        }
    }
    __syncthreads();
}

constexpr int LDS_BYTES = 150 * 1024;
constexpr int NPHASE = 18;
__global__ void __launch_bounds__(NTHREADS, 2) fwd_kernel(Args args) {
    extern __shared__ __attribute__((aligned(16))) unsigned char lds_raw[];
    Ctx F;
#pragma unroll
    for (int i = 0; i < 22; ++i) F.in[i] = args.in[i];
    F.out = args.out; F.ws = args.ws; F.lds = (LAS unsigned char*)lds_raw;
    F.tid = threadIdx.x; F.lane = F.tid & 63; F.wave = __builtin_amdgcn_readfirstlane(F.tid >> 6); F.blk = blockIdx.x; F.nblk = gridDim.x;
    const float* mod = (const float*)(F.ws + WS_MOD); const float* rt = (const float*)(F.ws + WS_ROPE);
    const int* tile_e = (const int*)(F.ws + WS_ROUTE + RT_TILEE);
    cg::grid_group grid = cg::this_grid();
    const int lo = args.ph_lo, hi = args.ph_hi;
    volatile LAS unsigned* bst = (volatile LAS unsigned*)(F.lds + LDS_BYTES - 16);
    if (F.tid < 4) bst[F.tid] = 0u;
    __syncthreads();
    XcdBarrier bar = xcd_barrier_post((unsigned*)(F.ws + WS_CTL) + 1024, bst);
    if (hi > NPHASE) grid.sync();
#ifndef REPEAT_MASK
#define REPEAT_MASK 0
#endif
#define PH(k) asm volatile("v_mbcnt_lo_u32_b32 %0, -1, 0\n\tv_mbcnt_hi_u32_b32 %0, -1, %0" : "=v"(F.lane)); F.tid = F.wave * 64 + F.lane; if (lo <= (k) && (k) < hi)
#define SEAM(k) do { if ((k) + 1 < hi) xcd_barrier(bar, F.tid == 0); } while (0)
    PH(0) { phase_prep(F); }
    PH(1) { wait_mod(F); phase_cvec(F); phase_norm0(F); SEAM(1); }
    PH(2) { { GemmDesc g{(const bf16_t*)(F.ws + WS_H), D, (const bf16_t*)(F.ws + WS_WIN0), D, NTOK / 256, ABIN / 256, nullptr, 0};
                  gemm_run(F, g, EpiIn0{(bf16_t*)(F.ws + WS_QKV), rt}); } SEAM(2); }
    PH(3) { phase_ret(F); asm volatile("v_mbcnt_lo_u32_b32 %0, -1, 0\n\tv_mbcnt_hi_u32_b32 %0, -1, %0" : "=v"(F.lane)); F.tid = F.wave * 64 + F.lane; phase_na(F); SEAM(3); }
    PH(4) { { GemmDesc g{(const bf16_t*)(F.ws + WS_MIX), D, (const bf16_t*)(F.ws + WS_WOUT0), D, NTOK / 256, 4, nullptr, 0};
                  gemm_run(F, g, EpiResT<true>{F.in[I_X], F.in[I_CTX], (bf16_t*)(F.ws + WS_XB), mod});  conv_tail(F, 64, 0); } SEAM(4); }
    PH(5) { phase_router(F, 0, NTOK); SEAM(5); }
    PH(6) { phase_slots(F, 0, NTOK); SEAM(6); }
    PH(7) { { GemmDesc g{(const bf16_t*)(F.ws + WS_H), D / 2, (const bf16_t*)(F.ws + WS_WGU), D / 2, tile_e[320], 4, tile_e, (size_t)512 * 1024, (const int*)(F.ws + WS_STOK)};
                  gemm_run(F, g, EpiGU{F.ws + WS_ACT}); } SEAM(7); }
    PH(8) { { GemmDesc g{(const bf16_t*)(F.ws + WS_ACT), FF / 2, (const bf16_t*)(F.ws + WS_WDN), FF / 2, tile_e[320], 4, tile_e, (size_t)1024 * 256};
                  gemm_run(F, g, EpiY{F.ws + WS_Y}); } SEAM(8); }
    PH(9) { phase_combine_w(F, 0); SEAM(9); }
    PH(10) { { GemmDesc g{(const bf16_t*)(F.ws + WS_H), D, (const bf16_t*)(F.ws + WS_WIN1), D, NL / 256, 6, nullptr, 0};
                   gemm_run(F, g, EpiIn1{(bf16_t*)(F.ws + WS_QKV), rt, 0, 0});
                   GemmDesc g2{(const bf16_t*)(F.ws + WS_H) + (size_t)NL * D, D, (const bf16_t*)(F.ws + WS_WIN1) + (size_t)1024 * D, D, NC / 256, 2, nullptr, 0};
                   gemm_run(F, g2, EpiIn1{(bf16_t*)(F.ws + WS_QKV), rt, 1024, NL});  conv_tail(F, 32, 6144); } SEAM(10); }
    PH(11) { phase_swa(F); SEAM(11); }
    PH(12) { { GemmDesc g{(const bf16_t*)(F.ws + WS_MIX), D, (const bf16_t*)(F.ws + WS_WOUT1), D, NL / 256, 4, nullptr, 0};
                   gemm_run(F, g, EpiResT<false>{nullptr, nullptr, (bf16_t*)(F.ws + WS_XB), mod + 17 * 6144}); } SEAM(12); }
    PH(13) { phase_router(F, 1, NL); SEAM(13); }
    PH(14) { phase_slots(F, 1, NL); SEAM(14); }
    PH(15) { { GemmDesc g{(const bf16_t*)(F.ws + WS_H), D / 2, (const bf16_t*)(F.ws + WS_WGU + (size_t)32 * 1024 * 1024), D / 2, tile_e[320], 4, tile_e, (size_t)512 * 1024, (const int*)(F.ws + WS_STOK)};
                   gemm_run(F, g, EpiGU{F.ws + WS_ACT}); } SEAM(15); }
    PH(16) { { GemmDesc g{(const bf16_t*)(F.ws + WS_ACT), FF / 2, (const bf16_t*)(F.ws + WS_WDN + (size_t)32 * 1024 * 512), FF / 2, tile_e[320], 4, tile_e, (size_t)1024 * 256};
                   gemm_run(F, g, EpiY{F.ws + WS_Y}); } SEAM(16); }
    PH(17) { phase_combine_w(F, 1); SEAM(17); }
#undef PH
#undef SEAM
}

extern "C" void kernel_launch(void* const* d_in, const int* in_sizes, int n_in, void* d_out, int out_size, void* d_ws, size_t ws_size, hipStream_t stream) {
    static int ready = 0, grid_blocks = 0;
    if (!ready) {
        if (n_in != 22 || out_size != NL * D || ws_size < WS_END) { fprintf(stderr, "kernel_launch: unexpected shapes (n_in %d out %d ws %zu)\n", n_in, out_size, ws_size); ready = -1; return; }
        if (hipFuncSetAttribute((const void*)fwd_kernel, hipFuncAttributeMaxDynamicSharedMemorySize, LDS_BYTES) != hipSuccess) { fprintf(stderr, "kernel_launch: hipFuncSetAttribute failed\n"); ready = -1; return; }
        int dev = 0, cus = 0, per_cu = 0;
        (void)hipGetDevice(&dev); (void)hipDeviceGetAttribute(&cus, hipDeviceAttributeMultiprocessorCount, dev);
        if (hipOccupancyMaxActiveBlocksPerMultiprocessor(&per_cu, (const void*)fwd_kernel, NTHREADS, LDS_BYTES) != hipSuccess || per_cu < 1) { fprintf(stderr, "kernel_launch: occupancy query failed (%d)\n", per_cu); ready = -1; return; }
        if (cus * per_cu < 256) { fprintf(stderr, "kernel_launch: needs 256 co-resident workgroups, device admits %d x %d\n", cus, per_cu); ready = -1; return; }
        grid_blocks = 256;
        ready = 1;
    }
    if (ready < 0) return;
    Args a{};
    for (int i = 0; i < 22; ++i) a.in[i] = (const float*)d_in[i];
    a.out = (float*)d_out; a.ws = (unsigned char*)d_ws;
    a.ph_lo = 0; a.ph_hi = NPHASE;
    if (hipMemsetAsync((char*)d_ws + WS_CTL, 0, 65536, stream) != hipSuccess) { fprintf(stderr, "kernel_launch: memset failed\n"); return; }
    void* kargs[] = {&a};
    hipError_t e = hipLaunchCooperativeKernel((const void*)fwd_kernel, dim3(grid_blocks), dim3(NTHREADS), kargs, LDS_BYTES, stream);
    if (e != hipSuccess) fprintf(stderr, "cooperative launch failed: %s (grid %d)\n", hipGetErrorString(e), grid_blocks);
}
```
